# Optimizing an MI355X kernel written in HIP

```python
import math
import jax, jax.numpy as jnp
from jax import lax
import numpy as np

D_MODEL = 2048
BATCH = 4
SEQ = 4096
DEPTH = 2

Q_BLOCK = 128
HALF_WIDTH = D_MODEL // 2
HEAD_DIM_SB = 128
N_HEADS_SB = HALF_WIDTH // HEAD_DIM_SB
N_HEADS_DSA = 16
HEAD_DIM_DSA = HALF_WIDTH // N_HEADS_DSA
N_HEADS_IDX = 8
HEAD_DIM_IDX = 64
TOPK_MAX = 256
N_HEADS_DIL = 16
HEAD_DIM_DIL = D_MODEL // N_HEADS_DIL
DILATED_CONFIGS = ((128, 1), (512, 4), (2048, 16))
N_BUCKETS = 32
BUCKET_MAX_DIST = 2048
N_BIAS_HEADS = 16
D_FF = 4 * D_MODEL
N_EVEN = (DEPTH + 1) // 2
N_ODD = DEPTH // 2
DN_ALPHA = (2 * DEPTH) ** 0.25
DN_BETA = (8 * DEPTH) ** -0.25
LN_EPS = 1e-5
NEG = -1e30

EVEN_WIDTHS = (HALF_WIDTH, HALF_WIDTH, HALF_WIDTH,
               HALF_WIDTH, HALF_WIDTH, HALF_WIDTH,
               N_HEADS_IDX * HEAD_DIM_IDX, HEAD_DIM_IDX,
               N_HEADS_IDX)
EVEN_IN = sum(EVEN_WIDTHS)
ODD_IN = 3 * N_HEADS_DIL * HEAD_DIM_DIL

kernel_name = 'hybrid_stickbreak_dsa_dilated_deepnorm'


def layer_norm(x, g, b):
    xf = x.astype(jnp.float32)
    mu = jnp.mean(xf, axis=-1, keepdims=True)
    var = jnp.mean(jnp.square(xf - mu), axis=-1, keepdims=True)
    y = (xf - mu) * lax.rsqrt(var + LN_EPS) * g.astype(jnp.float32) + b.astype(jnp.float32)
    return y.astype(x.dtype)


def rel_bucket(dist):
    max_exact = N_BUCKETS // 2
    d_f = jnp.maximum(dist, 1).astype(jnp.float32)
    large = max_exact + (jnp.log(d_f / max_exact) / math.log(BUCKET_MAX_DIST / max_exact)
                         * (N_BUCKETS - max_exact)).astype(jnp.int32)
    large = jnp.minimum(large, N_BUCKETS - 1)
    return jnp.where(dist < max_exact, dist, large)


def stick_breaking_attention(q, k, v):
    B, S, H, dh = q.shape
    nb = S // Q_BLOCK
    qb = q.reshape(B, nb, Q_BLOCK, H, dh).transpose(1, 0, 2, 3, 4)
    s_pos = jnp.arange(S)
    scale = dh ** -0.5

    def block(args):
        qblk, n = args
        t_pos = n * Q_BLOCK + jnp.arange(Q_BLOCK)
        z = jnp.einsum('bqhe,bshe->bhqs', qblk, k).astype(jnp.float32) * scale
        strict = s_pos[None, :] < t_pos[:, None]
        log_beta = jax.nn.log_sigmoid(z)
        log_keep = jnp.where(strict, jax.nn.log_sigmoid(-z), 0.0)
        later = lax.cumsum(log_keep, axis=3, reverse=True) - log_keep
        a = jnp.where(strict, jnp.exp(log_beta + later), 0.0)
        return jnp.einsum('bhqs,bshe->bqhe', a, v.astype(jnp.float32)).astype(q.dtype)

    o = lax.map(block, (qb, jnp.arange(nb)))
    return o.transpose(1, 0, 2, 3, 4).reshape(B, S, H, dh)


def dsa_attention(q, k, v, q_idx, k_idx, w_idx, rel_bias):
    B, S, H, dh = q.shape
    nb = S // Q_BLOCK
    top_k = min(TOPK_MAX, S // 4)
    kv = jnp.concatenate([k, v], axis=-1)
    s_pos = jnp.arange(S)
    scale = dh ** -0.5
    idx_scale = HEAD_DIM_IDX ** -0.5
    w_scale = N_HEADS_IDX ** -0.5
    qb = q.reshape(B, nb, Q_BLOCK, H, dh).transpose(1, 0, 2, 3, 4)
    qib = q_idx.reshape(B, nb, Q_BLOCK, N_HEADS_IDX, HEAD_DIM_IDX).transpose(1, 0, 2, 3, 4)
    wb = w_idx.reshape(B, nb, Q_BLOCK, N_HEADS_IDX).transpose(1, 0, 2, 3)
    table = rel_bias.astype(jnp.float32)

    def block(args):
        qblk, qiblk, wblk, n = args
        t_pos = n * Q_BLOCK + jnp.arange(Q_BLOCK)
        dots = jnp.einsum('bqhe,bse->bqhs', qiblk, k_idx).astype(jnp.float32) * idx_scale
        score = jnp.einsum('bqhs,bqh->bqs', jax.nn.relu(dots), wblk.astype(jnp.float32) * w_scale)
        causal = s_pos[None, :] <= t_pos[:, None]
        score = jnp.where(causal[None], score, NEG)
        _, sel = lax.top_k(score, top_k)
        valid = sel <= t_pos[None, :, None]
        kv_sel = jax.vmap(lambda kvb, ib: kvb[ib])(kv, sel)
        k_sel, v_sel = jnp.split(kv_sel, 2, axis=-1)
        logits = jnp.einsum('bqhe,bqkhe->bhqk', qblk, k_sel).astype(jnp.float32) * scale
        dist = jnp.maximum(t_pos[None, :, None] - sel, 0)
        logits = logits + table[rel_bucket(dist)].transpose(0, 3, 1, 2)
        logits = jnp.where(valid[:, None], logits, NEG)
        p = jax.nn.softmax(logits, axis=-1)
        return jnp.einsum('bhqk,bqkhe->bqhe', p, v_sel.astype(jnp.float32)).astype(q.dtype)

    o = lax.map(block, (qb, qib, wb, jnp.arange(nb)))
    return o.transpose(1, 0, 2, 3, 4).reshape(B, S, H, dh)


def dilated_branch(q, k, v, rel_bias, window, dilation):
    B, S, H, dh = q.shape
    span = window // dilation
    chunk = dilation * Q_BLOCK
    Sp = -(-S // chunk) * chunk
    pad = Sp - S
    M = Sp // dilation
    nblk = M // Q_BLOCK

    def to_sub(a):
        a = jnp.pad(a, ((0, 0), (0, pad), (0, 0), (0, 0)))
        a = a.reshape(B, M, dilation, H, dh).transpose(0, 2, 1, 3, 4)
        return a.reshape(B, dilation, nblk, Q_BLOCK, H, dh)

    def with_prev(a):
        prev = jnp.pad(a, ((0, 0), (0, 0), (1, 0), (0, 0), (0, 0), (0, 0)))[:, :, :-1]
        return jnp.concatenate([prev, a], axis=3)

    qs = to_sub(q)
    kk = with_prev(to_sub(k))
    vv = with_prev(to_sub(v))
    logits = jnp.einsum('brnqhe,brnkhe->brnhqk', qs, kk).astype(jnp.float32) * (dh ** -0.5)
    i = jnp.arange(Q_BLOCK)[:, None]
    c = jnp.arange(2 * Q_BLOCK)[None, :]
    j = Q_BLOCK + i - c
    band = (j >= 0) & (j <= span)
    valid = band[None] & ((jnp.arange(nblk)[:, None, None] > 0) | (c >= Q_BLOCK)[None])
    bias = rel_bias.astype(jnp.float32)[rel_bucket(jnp.maximum(j, 0) * dilation)]
    logits = logits + bias.transpose(2, 0, 1)
    logits = jnp.where(valid[:, None], logits, NEG)
    m = jnp.max(logits, axis=-1, keepdims=True)
    e = jnp.exp(logits - m)
    s = jnp.sum(e, axis=-1)
    o = jnp.einsum('brnhqk,brnkhe->brnqhe', e, vv.astype(jnp.float32))
    o = o / s.transpose(0, 1, 2, 4, 3)[..., None]
    o = o.reshape(B, dilation, M, H, dh).transpose(0, 2, 1, 3, 4).reshape(B, Sp, H, dh)[:, :S]

    def stat_back(a):
        a = a.transpose(0, 1, 2, 4, 3).reshape(B, dilation, M, H)
        return a.transpose(0, 2, 1, 3).reshape(B, Sp, H)[:, :S]

    return o, stat_back(m[..., 0]), stat_back(s)


def dilated_attention(q, k, v, rel_bias):
    outs, maxes, dens = [], [], []
    for window, dilation in DILATED_CONFIGS:
        o, m, s = dilated_branch(q, k, v, rel_bias, window, dilation)
        outs.append(o)
        maxes.append(m)
        dens.append(s)
    o = jnp.stack(outs)
    m = jnp.stack(maxes)
    s = jnp.stack(dens)
    w = s * jnp.exp(m - jnp.max(m, axis=0, keepdims=True))
    out = jnp.sum(w[..., None] * o, axis=0) / jnp.sum(w, axis=0)[..., None]
    return out.astype(q.dtype)


def even_mixer(x, w_in, w_out, rel_bias):
    B, S, _ = x.shape
    h = x @ w_in
    offsets = [int(o) for o in np.cumsum(EVEN_WIDTHS)[:-1]]
    qa, ka, va, qb, kb, vb, qi, ki, wi = jnp.split(h, offsets, axis=-1)
    sb_shape = (B, S, N_HEADS_SB, HEAD_DIM_SB)
    dsa_shape = (B, S, N_HEADS_DSA, HEAD_DIM_DSA)
    oa = stick_breaking_attention(qa.reshape(sb_shape), ka.reshape(sb_shape), va.reshape(sb_shape))
    ob = dsa_attention(qb.reshape(dsa_shape), kb.reshape(dsa_shape), vb.reshape(dsa_shape),
                       qi.reshape(B, S, N_HEADS_IDX, HEAD_DIM_IDX), ki, wi, rel_bias)
    o = jnp.concatenate([oa.reshape(B, S, HALF_WIDTH), ob.reshape(B, S, HALF_WIDTH)], axis=-1)
    return o @ w_out


def odd_mixer(x, w_in, w_out, rel_bias):
    B, S, _ = x.shape
    q, k, v = jnp.split(x @ w_in, 3, axis=-1)
    shp = (B, S, N_HEADS_DIL, HEAD_DIM_DIL)
    o = dilated_attention(q.reshape(shp), k.reshape(shp), v.reshape(shp), rel_bias)
    return o.reshape(B, S, N_HEADS_DIL * HEAD_DIM_DIL) @ w_out


def sqrelu_mlp(x, w1, w2):
    return jnp.square(jax.nn.relu(x @ w1)) @ w2


def setup_inputs(seed: int = 0) -> dict:
    key = jax.random.key(seed)
    ks = jax.random.split(key, 12)
    f32 = jnp.float32
    even_scale = np.concatenate([
        np.ones(2 * HALF_WIDTH), np.full(HALF_WIDTH, DN_BETA),
        np.ones(2 * HALF_WIDTH), np.full(HALF_WIDTH, DN_BETA),
        np.ones(N_HEADS_IDX * HEAD_DIM_IDX + HEAD_DIM_IDX + N_HEADS_IDX)]).astype(np.float32)
    odd_scale = np.concatenate([np.ones(2 * D_MODEL), np.full(D_MODEL, DN_BETA)]).astype(np.float32)
    x = jax.random.normal(ks[0], (BATCH, SEQ, D_MODEL), f32)
    even_w_in = jax.random.normal(ks[1], (N_EVEN, D_MODEL, EVEN_IN), f32) * (D_MODEL ** -0.5) * jnp.asarray(even_scale)
    even_w_out = jax.random.normal(ks[2], (N_EVEN, 2 * HALF_WIDTH, D_MODEL), f32) * ((2 * HALF_WIDTH) ** -0.5 * DN_BETA)
    odd_w_in = jax.random.normal(ks[3], (N_ODD, D_MODEL, ODD_IN), f32) * (D_MODEL ** -0.5) * jnp.asarray(odd_scale)
    odd_w_out = jax.random.normal(ks[4], (N_ODD, D_MODEL, D_MODEL), f32) * (D_MODEL ** -0.5 * DN_BETA)
    rel_bias = jax.random.normal(ks[5], (N_BUCKETS, N_BIAS_HEADS), f32) * 0.5
    ln_mix_g = 1.0 + 0.05 * jax.random.normal(ks[6], (DEPTH, D_MODEL), f32)
    ln_mix_b = 0.02 * jax.random.normal(ks[7], (DEPTH, D_MODEL), f32)
    ffn_w1 = jax.random.normal(ks[8], (DEPTH, D_MODEL, D_FF), f32) * (D_MODEL ** -0.5 * DN_BETA)
    ffn_w2 = jax.random.normal(ks[9], (DEPTH, D_FF, D_MODEL), f32) * (D_FF ** -0.5 * DN_BETA)
    ln_ffn_g = 1.0 + 0.05 * jax.random.normal(ks[10], (DEPTH, D_MODEL), f32)
    ln_ffn_b = 0.02 * jax.random.normal(ks[11], (DEPTH, D_MODEL), f32)
    return {'x': x, 'even_w_in': even_w_in, 'even_w_out': even_w_out,
            'odd_w_in': odd_w_in, 'odd_w_out': odd_w_out, 'rel_bias': rel_bias,
            'ln_mix_g': ln_mix_g, 'ln_mix_b': ln_mix_b, 'ffn_w1': ffn_w1, 'ffn_w2': ffn_w2,
            'ln_ffn_g': ln_ffn_g, 'ln_ffn_b': ln_ffn_b}


def reference(x, even_w_in, even_w_out, odd_w_in, odd_w_out, rel_bias,
              ln_mix_g, ln_mix_b, ffn_w1, ffn_w2, ln_ffn_g, ln_ffn_b):
    for layer in range(DEPTH):
        if layer % 2 == 0:
            mix = even_mixer(x, even_w_in[layer // 2], even_w_out[layer // 2], rel_bias)
        else:
            mix = odd_mixer(x, odd_w_in[layer // 2], odd_w_out[layer // 2], rel_bias)
        x = layer_norm(DN_ALPHA * x + mix, ln_mix_g[layer], ln_mix_b[layer])
        x = layer_norm(DN_ALPHA * x + sqrelu_mlp(x, ffn_w1[layer], ffn_w2[layer]),
                       ln_ffn_g[layer], ln_ffn_b[layer])
    return x
```

```cpp
#include <hip/hip_runtime.h>
#include <hip/hip_cooperative_groups.h>
#include <cstdio>
#include <cstdint>
namespace cg = cooperative_groups;
namespace pg8 {
#define PG8_LAS __attribute__((address_space(3)))
typedef unsigned short bf16_t;
typedef short bf16x8 __attribute__((ext_vector_type(8)));
typedef float f32x4 __attribute__((ext_vector_type(4)));
typedef unsigned u32x4 __attribute__((ext_vector_type(4)));
constexpr int BM = 256, BK = 64, HALF = 128, HTB = HALF * BK * 2  , STAGE_BYTES = 8 * HTB, NXCD = 8, WGM = 8;

__host__ __device__ __forceinline__ int lds_byte(int r, int c) { const int st = (r >> 4) * 2 + (c >> 5), rr = r & 15, cc = c & 31, ob = rr * 64 + cc * 2; return st * 1024 + (ob ^ (((ob >> 9) & 1) << 5)); }
__host__ __device__ __forceinline__ void stage_rc(int b, int& R, int& C) { const int st = b / 1024, sb = b % 1024, swz = sb ^ (((sb >> 9) & 1) << 5); R = (st >> 1) * 16 + swz / 64; C = (st & 1) * 32 + (swz % 64) / 2; }
__host__ __device__ __forceinline__ int perm32(int rho) { const int n = rho >> 4, i = rho & 15; return 8 * (i >> 2) + 4 * n + (i & 3); }

struct Unit { int pm, pn; };
struct Gemm { const bf16_t* A; const bf16_t* Bt; int M, N, K; };

struct StaticOrder {
    int nM, nN, nwg, G, c;
    __host__ __device__ void init(int M, int N, int G_, int c_) { nM = M / BM; nN = N / BM; nwg = nM * nN; G = G_; c = c_; }
    __host__ __device__ bool next(int i, Unit& u) const {
        const long L = (long)i * G + c; if (L >= nwg) return false;
        int wgid = (int)L; { const int q = nwg / NXCD, r = nwg % NXCD, xcd = wgid % NXCD, off = wgid / NXCD; wgid = (xcd < r ? xcd * (q + 1) : r * (q + 1) + (xcd - r) * q) + off; }
        const int nig = WGM * nN, gid = wgid / nig, fm = gid * WGM, gsz = (nM - fm) < WGM ? (nM - fm) : WGM;
        u.pm = fm + ((wgid % nig) % gsz); u.pn = (wgid % nig) / gsz; return true;
    }
    __device__ __forceinline__ void a_ready(const Unit&) const {}
    __device__ __forceinline__ void done(const Unit&) const {}
};

__device__ __forceinline__ unsigned cvt_pk_bf16(float lo, float hi) { unsigned r; asm volatile("v_cvt_pk_bf16_f32 %0, %1, %2" : "=v"(r) : "v"(lo), "v"(hi)); return r; }
template <int ACT> struct EpiBf16 {
    static constexpr bool PERM = true, AFTER_DRAIN = false;
    bf16_t* O; int ldc;
    __device__ __forceinline__ void operator()(const f32x4 (&acc)[2][2][4][2], const Unit& u, int wr, int wc, int fr, int fq) const {
        const int row0 = u.pm * BM + wr * 64 + fr; const int col0 = u.pn * BM + wc * 32 + 8 * fq;
#pragma unroll
        for (int ai = 0; ai < 2; ++ai)
#pragma unroll
            for (int m = 0; m < 4; ++m) { bf16_t* rowp = O + (size_t)(row0 + ai * HALF + m * 16) * ldc + col0;
#pragma unroll
                for (int bj = 0; bj < 2; ++bj) { f32x4 v0 = acc[ai][bj][m][0], v1 = acc[ai][bj][m][1];
                    if (ACT == 2) {
#pragma unroll
                        for (int q = 0; q < 4; ++q) { float a = v0[q] > 0.f ? v0[q] : 0.f; v0[q] = a * a; float b = v1[q] > 0.f ? v1[q] : 0.f; v1[q] = b * b; } }
                    u32x4 w; w.x = cvt_pk_bf16(v0[0], v0[1]); w.y = cvt_pk_bf16(v0[2], v0[3]); w.z = cvt_pk_bf16(v1[0], v1[1]); w.w = cvt_pk_bf16(v1[2], v1[3]);
                    *(u32x4*)(rowp + bj * HALF) = w; } }
    }
};
struct EpiResF32 {
    static constexpr bool PERM = true, AFTER_DRAIN = false;
    const float* res; float* out; int ldc; float alpha;
    __device__ __forceinline__ void operator()(const f32x4 (&acc)[2][2][4][2], const Unit& u, int wr, int wc, int fr, int fq) const {
        const int row0 = u.pm * BM + wr * 64 + fr; const int col0 = u.pn * BM + wc * 32 + 8 * fq;
#pragma unroll
        for (int ai = 0; ai < 2; ++ai)
#pragma unroll
            for (int m = 0; m < 4; ++m) { const size_t off = (size_t)(row0 + ai * HALF + m * 16) * ldc + col0;
#pragma unroll
                for (int bj = 0; bj < 2; ++bj) { const size_t p = off + bj * HALF;
                    const f32x4 r0 = *(const f32x4*)(res + p), r1 = *(const f32x4*)(res + p + 4);
                    *(f32x4*)(out + p) = r0 * alpha + acc[ai][bj][m][0]; *(f32x4*)(out + p + 4) = r1 * alpha + acc[ai][bj][m][1]; } }
    }
};

struct EpiResLnF32 {
    static constexpr bool PERM = true, AFTER_DRAIN = false;
    const float* res; float* out; int ldc; float alpha; const float* stats; const float* g; const float* b;
    __device__ __forceinline__ void operator()(const f32x4 (&acc)[2][2][4][2], const Unit& u, int wr, int wc, int fr, int fq) const {
        const int row0 = u.pm * BM + wr * 64 + fr; const int col0 = u.pn * BM + wc * 32 + 8 * fq;
#pragma unroll
        for (int bj = 0; bj < 2; ++bj) {
            const f32x4 g0 = *(const f32x4*)(g + col0 + bj * HALF), g1 = *(const f32x4*)(g + col0 + bj * HALF + 4);
            const f32x4 b0 = *(const f32x4*)(b + col0 + bj * HALF), b1 = *(const f32x4*)(b + col0 + bj * HALF + 4);
#pragma unroll
            for (int ai = 0; ai < 2; ++ai)
#pragma unroll
                for (int m = 0; m < 4; ++m) { const int row = row0 + ai * HALF + m * 16; const size_t p = (size_t)row * ldc + col0 + bj * HALF;
                    const float mean = stats[2 * row], rstd = stats[2 * row + 1];
                    const f32x4 r0 = *(const f32x4*)(res + p), r1 = *(const f32x4*)(res + p + 4);
                    const f32x4 n0 = (r0 - mean) * rstd * g0 + b0, n1 = (r1 - mean) * rstd * g1 + b1;
                    *(f32x4*)(out + p) = n0 * alpha + acc[ai][bj][m][0]; *(f32x4*)(out + p + 4) = n1 * alpha + acc[ai][bj][m][1]; }
        }
    }
};

struct EpiBf16HeadMajor {
    static constexpr bool PERM = true, AFTER_DRAIN = false;
    bf16_t* O;
    __device__ __forceinline__ void operator()(const f32x4 (&acc)[2][2][4][2], const Unit& u, int wr, int wc, int fr, int fq) const {
        const int row0 = u.pm * BM + wr * 64 + fr; const int col0 = u.pn * BM + wc * 32 + 8 * fq;
#pragma unroll
        for (int bj = 0; bj < 2; ++bj) { const int col = col0 + bj * HALF; const int which = col >> 11, h = (col >> 7) & 15, e = col & 127;
            bf16_t* base = O + (size_t)which * (16384u * 2048u) + (size_t)h * (4096u * 128u) + e;
#pragma unroll
            for (int ai = 0; ai < 2; ++ai)
#pragma unroll
                for (int m = 0; m < 4; ++m) { const int row = row0 + ai * HALF + m * 16; const int bb = row >> 12, s = row & 4095;
                    const f32x4 v0 = acc[ai][bj][m][0], v1 = acc[ai][bj][m][1];
                    u32x4 w; w.x = cvt_pk_bf16(v0[0], v0[1]); w.y = cvt_pk_bf16(v0[2], v0[3]); w.z = cvt_pk_bf16(v1[0], v1[1]); w.w = cvt_pk_bf16(v1[2], v1[3]);
                    *(u32x4*)(base + ((size_t)bb * 16 * 4096 + s) * 128) = w; } }
    }
};
template <class Epi, class Sched, bool ALIGN_EPI = false, bool SP2 = false>
__device__ __forceinline__ void gemm_phase(PG8_LAS unsigned char* lds, const Gemm g, const Sched& S, const Epi& E) {
    const int tid = threadIdx.x, wid = __builtin_amdgcn_readfirstlane(tid >> 6), lane = tid & 63, wr = wid >> 2, wc = wid & 3, fr = lane & 15, fq = lane >> 4;
    const int K = g.K, nt = K / BK;
    unsigned voffA[2], voffB[2];
#pragma unroll
    for (int i = 0; i < 2; ++i) { int R, C; stage_rc(tid * 16 + i * 8192, R, C); const int Rb = Epi::PERM ? ((R & ~31) + perm32(R & 31)) : R;
        voffA[i] = (unsigned)(R * K + C) * 2u; voffB[i] = (unsigned)(Rb * K + C) * 2u; }
    const size_t kstep = (size_t)(BK * 2);
    const size_t hstep = (size_t)HALF * K * 2;
    const size_t tstep = 2 * hstep;
    const unsigned ldsw = (unsigned)wid * 1024u;
    const int aoff = lds_byte(wr * 64 + fr, fq * 8), boff = lds_byte(wc * 32 + fr, fq * 8);
#define PG8_SA(b, h) (((b) * 2 + (h)) * HTB)
#define PG8_SB(b, h) ((4 + (b) * 2 + (h)) * HTB)
#define PG8_STAGE(bufoff, gbase, voff) do { _Pragma("unroll") for (int _i = 0; _i < 2; ++_i) \
        __builtin_amdgcn_global_load_lds((const unsigned*)((const char*)(gbase) + (voff)[_i]), (PG8_LAS unsigned*)(lds + (bufoff) + ldsw + _i * 8192), 16, 0, 0); } while (0)
#define PG8_LDA(dst, b, h) do { _Pragma("unroll") for (int m = 0; m < 4; ++m) _Pragma("unroll") for (int k = 0; k < 2; ++k) dst[m][k] = *(const PG8_LAS bf16x8*)(lds + PG8_SA(b, h) + aoff + m * 2048 + k * 1024); } while (0)
#define PG8_LDB(dst, b, h) do { _Pragma("unroll") for (int n = 0; n < 2; ++n) _Pragma("unroll") for (int k = 0; k < 2; ++k) dst[n][k] = *(const PG8_LAS bf16x8*)(lds + PG8_SB(b, h) + boff + n * 2048 + k * 1024); } while (0)
#define PG8_MMA(ai, bj, At, Bt) do { __builtin_amdgcn_s_setprio(1); _Pragma("unroll") for (int m = 0; m < 4; ++m) _Pragma("unroll") for (int n = 0; n < 2; ++n) _Pragma("unroll") for (int k = 0; k < 2; ++k) \
        acc[ai][bj][m][n] = __builtin_amdgcn_mfma_f32_16x16x32_bf16(Bt[n][k], At[m][k], acc[ai][bj][m][n], 0, 0, 0); __builtin_amdgcn_s_setprio(0); } while (0)
#define PG8_WAIT_V(n) asm volatile("s_waitcnt vmcnt(" #n ")" ::: "memory")
#define PG8_WAIT_L(n) asm volatile("s_waitcnt lgkmcnt(" #n ")" ::: "memory")
#define PG8_BAR __builtin_amdgcn_s_barrier()
#define PG8_SCHED __builtin_amdgcn_sched_barrier(0)
    Unit cur, nxt; int ui = 0;
    if (!S.next(0, cur)) return;
    f32x4 acc[2][2][4][2];
#pragma unroll
    for (int a = 0; a < 2; ++a)
#pragma unroll
        for (int b = 0; b < 2; ++b)
#pragma unroll
            for (int m = 0; m < 4; ++m)
#pragma unroll
                for (int n = 0; n < 2; ++n) acc[a][b][m][n] = (f32x4){0.f, 0.f, 0.f, 0.f};
    bf16x8 At[4][2], B0[2][2], B1[2][2];
    const char* cA = (const char*)g.A + (size_t)cur.pm * tstep; const char* cB = (const char*)g.Bt + (size_t)cur.pn * tstep;
    S.a_ready(cur);
    if constexpr (SP2) {
        PG8_STAGE(PG8_SB(0, 0), cB, voffB); PG8_STAGE(PG8_SB(0, 1), cB + hstep, voffB); PG8_STAGE(PG8_SA(0, 0), cA, voffA); PG8_STAGE(PG8_SA(0, 1), cA + hstep, voffA);
        if (wr == 1) PG8_BAR;
        PG8_WAIT_V(2); PG8_BAR;
        PG8_STAGE(PG8_SB(1, 0), cB + kstep, voffB); PG8_STAGE(PG8_SA(1, 0), cA + kstep, voffA); PG8_STAGE(PG8_SB(1, 1), cB + hstep + kstep, voffB);
        PG8_WAIT_V(6); PG8_BAR;
    } else {
        PG8_STAGE(PG8_SB(0, 0), cB, voffB); PG8_STAGE(PG8_SA(0, 0), cA, voffA); PG8_STAGE(PG8_SB(0, 1), cB + hstep, voffB); PG8_STAGE(PG8_SA(0, 1), cA + hstep, voffA);
        if (wr == 1) PG8_BAR;
        PG8_WAIT_V(4); PG8_BAR;
        PG8_STAGE(PG8_SB(1, 0), cB + kstep, voffB); PG8_STAGE(PG8_SA(1, 0), cA + kstep, voffA); PG8_STAGE(PG8_SB(1, 1), cB + hstep + kstep, voffB);
        PG8_WAIT_V(6); PG8_BAR;
    }
    for (;;) {
        const bool has_next = S.next(ui + 1, nxt);
        const char* nA = has_next ? (const char*)g.A + (size_t)nxt.pm * tstep : cA; const char* nB = has_next ? (const char*)g.Bt + (size_t)nxt.pn * tstep : cB;
        for (int t = 0; t < nt; t += 2) {
            const bool last = (t == nt - 2);
            const char* a1 = cA + (size_t)(t + 1) * kstep;
            const char* a2 = last ? nA : cA + (size_t)(t + 2) * kstep; const char* b2 = last ? nB : cB + (size_t)(t + 2) * kstep;
            const char* a3 = a2 + kstep; const char* b3 = b2 + kstep;
            if (last && has_next) S.a_ready(nxt);
            if constexpr (SP2) {
            PG8_LDB(B0, 0, 0); PG8_LDB(B1, 0, 1); PG8_SCHED; PG8_LDA(At, 0, 0); PG8_STAGE(PG8_SA(1, 1), a1 + hstep, voffA);
            PG8_WAIT_V(8); PG8_WAIT_L(0); PG8_BAR; PG8_MMA(0, 0, At, B0); PG8_MMA(0, 1, At, B1); PG8_BAR; PG8_SCHED;
            PG8_LDA(At, 0, 1); PG8_STAGE(PG8_SB(0, 0), b2, voffB); PG8_STAGE(PG8_SB(0, 1), b2 + hstep, voffB); PG8_STAGE(PG8_SA(0, 0), a2, voffA);
            PG8_WAIT_V(8); PG8_WAIT_L(0); PG8_BAR; PG8_MMA(1, 0, At, B0); PG8_MMA(1, 1, At, B1); PG8_BAR; PG8_SCHED;
            PG8_LDB(B0, 1, 0); PG8_LDB(B1, 1, 1); PG8_SCHED; PG8_LDA(At, 1, 0); PG8_STAGE(PG8_SA(0, 1), a2 + hstep, voffA);
            PG8_WAIT_V(8); PG8_WAIT_L(0); PG8_BAR; PG8_MMA(0, 0, At, B0); PG8_MMA(0, 1, At, B1); PG8_BAR; PG8_SCHED;
            PG8_LDA(At, 1, 1); PG8_STAGE(PG8_SB(1, 0), b3, voffB); PG8_STAGE(PG8_SB(1, 1), b3 + hstep, voffB); PG8_STAGE(PG8_SA(1, 0), a3, voffA);
            PG8_WAIT_V(8); PG8_WAIT_L(0); PG8_BAR; PG8_MMA(1, 0, At, B0); PG8_MMA(1, 1, At, B1); PG8_BAR; PG8_SCHED;
            } else {
            PG8_LDB(B0, 0, 0); PG8_SCHED; PG8_LDA(At, 0, 0); PG8_STAGE(PG8_SA(1, 1), a1 + hstep, voffA);
            PG8_WAIT_L(8); PG8_BAR; PG8_WAIT_L(0); PG8_MMA(0, 0, At, B0); PG8_BAR; PG8_SCHED;
            PG8_LDB(B1, 0, 1); PG8_STAGE(PG8_SB(0, 0), b2, voffB);
            PG8_BAR; PG8_WAIT_L(0); PG8_MMA(0, 1, At, B1); PG8_BAR;
            PG8_LDA(At, 0, 1); PG8_STAGE(PG8_SA(0, 0), a2, voffA);
            PG8_BAR; PG8_WAIT_L(0); PG8_MMA(1, 0, At, B0); PG8_BAR; PG8_SCHED;
            PG8_STAGE(PG8_SB(0, 1), b2 + hstep, voffB);
            PG8_WAIT_V(6); PG8_BAR; PG8_MMA(1, 1, At, B1); PG8_BAR;
            PG8_LDB(B0, 1, 0); PG8_SCHED; PG8_LDA(At, 1, 0); PG8_STAGE(PG8_SA(0, 1), a2 + hstep, voffA);
            PG8_WAIT_L(8); PG8_BAR; PG8_WAIT_L(0); PG8_MMA(0, 0, At, B0); PG8_BAR; PG8_SCHED;
            PG8_LDB(B1, 1, 1); PG8_STAGE(PG8_SB(1, 0), b3, voffB);
            PG8_BAR; PG8_WAIT_L(0); PG8_MMA(0, 1, At, B1); PG8_BAR;
            PG8_LDA(At, 1, 1); PG8_STAGE(PG8_SA(1, 0), a3, voffA);
            PG8_BAR; PG8_WAIT_L(0); PG8_MMA(1, 0, At, B0); PG8_BAR; PG8_SCHED;
            PG8_STAGE(PG8_SB(1, 1), b3 + hstep, voffB);
            PG8_WAIT_V(6); PG8_BAR; PG8_MMA(1, 1, At, B1); PG8_BAR;
            }
        }
        if constexpr (ALIGN_EPI) { if (wr == 0) PG8_BAR; }
        if constexpr (!Epi::AFTER_DRAIN) { E(acc, cur, wr, wc, fr, fq); S.done(cur); }
        if (!has_next) break;
#pragma unroll
        for (int a = 0; a < 2; ++a)
#pragma unroll
            for (int b = 0; b < 2; ++b)
#pragma unroll
                for (int m = 0; m < 4; ++m)
#pragma unroll
                    for (int n = 0; n < 2; ++n) acc[a][b][m][n] = (f32x4){0.f, 0.f, 0.f, 0.f};
        cur = nxt; cA = nA; cB = nB; ++ui;
        if constexpr (ALIGN_EPI) { if (wr == 1) PG8_BAR; }
    }
    PG8_WAIT_V(0);
    if constexpr (!ALIGN_EPI) { if (wr == 0) PG8_BAR; }
    PG8_BAR;
    if constexpr (Epi::AFTER_DRAIN) { E.fused(acc, cur, wr, wc, fr, fq, lds, wid, lane); S.done(cur); }
#undef PG8_SA
#undef PG8_SB
#undef PG8_STAGE
#undef PG8_LDA
#undef PG8_LDB
#undef PG8_MMA
#undef PG8_WAIT_V
#undef PG8_WAIT_L
#undef PG8_BAR
#undef PG8_SCHED
}
}

constexpr int BATCH = 4, SEQ = 4096, DM = 2048, MTOK = BATCH * SEQ;
constexpr int EVEN_IN = 6728, EVEN_LD = 6912, ODD_IN = 6144, DFF = 8192;
constexpr int NWAVES = 8, NTHR = NWAVES * 64;
constexpr float DN_ALPHA = 1.4142135623730951f, LN_EPS = 1e-5f, LOG2E = 1.4426950408889634f;
constexpr float C_D128 = 0.08838834764831845f * LOG2E, C_D64 = 0.125f * LOG2E;
constexpr int C_QA = 0, C_KA = 1024, C_VA = 2048, C_QB = 3072, C_KB = 4096, C_VB = 5120, C_QI = 6144, C_KI = 6656, C_WI = 6720;
#ifndef MK_PER_PHASE
#define MK_PER_PHASE 0
#endif
constexpr int N_PHASES = 17;
#ifndef PG8_ALIGN
#define PG8_ALIGN true
#endif
#ifndef PG8_SP2
#define PG8_SP2 true
#endif
#ifndef PROBE_PHASE
#define PROBE_PHASE -1
#endif
#define REPS(k) for (int _rep = 0; _rep < ((PROBE_PHASE) == (k) ? 2 : 1); ++_rep)

constexpr size_t MiB = 1u << 20;
constexpr size_t WS_BIASD = 1 * MiB;
constexpr size_t WS_BIASDIL = 1 * MiB + 512 * 1024;
constexpr size_t WS_MASK = 2 * MiB;
constexpr size_t WS_STAT = 10 * MiB;
constexpr size_t WS_KMAX = 1 * MiB + 768 * 1024;
constexpr size_t WS_LNST = 17 * MiB;
constexpr size_t WS_WIN = 20 * MiB, WS_WOUT = 47 * MiB, WS_W1 = 55 * MiB, WS_W2 = 87 * MiB;
constexpr size_t WS_XB = 120 * MiB;
constexpr size_t WS_BIG = 184 * MiB;
constexpr size_t WS_OG = WS_BIG + 192 * MiB;
constexpr size_t WS_END = 504 * MiB;

constexpr int LDS_BYTES = 147456;

#define LAS __attribute__((address_space(3)))
typedef unsigned short bf16;
typedef short bf16x8 __attribute__((ext_vector_type(8)));
typedef short s16x4 __attribute__((ext_vector_type(4)));
typedef float f32x4 __attribute__((ext_vector_type(4)));
typedef float f32x16 __attribute__((ext_vector_type(16)));
typedef unsigned u32x4 __attribute__((ext_vector_type(4)));
typedef unsigned u32x2 __attribute__((ext_vector_type(2)));
typedef float f32x2_t __attribute__((ext_vector_type(2)));
typedef __bf16 bf16x2_t __attribute__((ext_vector_type(2)));
typedef short v4i16_t __attribute__((ext_vector_type(4)));
#define DI __device__ __forceinline__
#define MFMA32(a, b, c) __builtin_amdgcn_mfma_f32_32x32x16_bf16((a), (b), (c), 0, 0, 0)

DI unsigned cvtpk(float lo, float hi) { f32x2_t v = {lo, hi}; bf16x2_t b = __builtin_convertvector(v, bf16x2_t); return __builtin_bit_cast(unsigned, b); }
DI float bf2f(unsigned short h) { return __uint_as_float(((unsigned)h) << 16); }
DI int crow(int i, int h) { return (i & 3) + 8 * (i >> 2) + 4 * h; }
DI float ex2(float x) { return __builtin_amdgcn_exp2f(x); }
DI float lg2(float x) { return __builtin_amdgcn_logf(x); }
DI float swap_max(float m) { auto rr = __builtin_amdgcn_permlane32_swap(__float_as_uint(m), __float_as_uint(m), false, false); return fmaxf(__uint_as_float(rr[0]), __uint_as_float(rr[1])); }
DI float swap_sum(float m) { auto rr = __builtin_amdgcn_permlane32_swap(__float_as_uint(m), __float_as_uint(m), false, false); return __uint_as_float(rr[0]) + __uint_as_float(rr[1]); }
DI float swap_other(float m, int hf) { auto rr = __builtin_amdgcn_permlane32_swap(__float_as_uint(m), __float_as_uint(m), false, false); return hf ? __uint_as_float(rr[0]) : __uint_as_float(rr[1]); }
DI bf16x8 pack8(const f32x16& x, int s) {
    u32x4 p; p.x = cvtpk(x[8 * s], x[8 * s + 1]); p.y = cvtpk(x[8 * s + 2], x[8 * s + 3]); p.z = cvtpk(x[8 * s + 4], x[8 * s + 5]); p.w = cvtpk(x[8 * s + 6], x[8 * s + 7]);
    return __builtin_bit_cast(bf16x8, p);
}
DI s16x4 vtr(LAS const char* p) { return __builtin_bit_cast(s16x4, __builtin_amdgcn_ds_read_tr16_b64_v4i16((LAS v4i16_t*)p)); }
DI int rel_bucket(int d) {
    if (d < 16) return d;
    const float df = (float)d;
    int large = 16 + (int)(logf(df / 16.f) / 4.852030263919617f * 16.f);
    return large < 31 ? large : 31;
}

struct Frame {
    LAS unsigned char* lds;
    int tid, lane, wave, G, bid;
    const float* in[12]; float* out; unsigned char* ws;
};

DI void transpose_item(const float* W, int K, int N, bf16* WT, LAS float* scr, int item, int nblk, int lane) {
    const int kb = item / nblk, nb = item % nblk, k0 = 64 * kb, n0 = 32 * nb;
    const int nn = n0 + (lane & 31);
    float wreg[32];
#pragma unroll
    for (int i = 0; i < 32; ++i) { const int kk = 2 * i + (lane >> 5); wreg[i] = (nn < N) ? __builtin_nontemporal_load(W + (size_t)(k0 + kk) * N + nn) : 0.f; }
#pragma unroll
    for (int i = 0; i < 32; ++i) { const int kk = 2 * i + (lane >> 5); scr[kk * 33 + (lane & 31)] = wreg[i]; }
    asm volatile("s_waitcnt lgkmcnt(0)" ::: "memory");
    const int c = lane & 7;
#pragma unroll
    for (int j = 0; j < 4; ++j) { const int n = (lane >> 3) + 8 * j; const LAS float* s = scr + (8 * c) * 33 + n;
        u32x4 o; o.x = cvtpk(s[0 * 33], s[1 * 33]); o.y = cvtpk(s[2 * 33], s[3 * 33]); o.z = cvtpk(s[4 * 33], s[5 * 33]); o.w = cvtpk(s[6 * 33], s[7 * 33]);
        *(u32x4*)(WT + (size_t)(n0 + n) * K + k0 + 8 * c) = o; }
    asm volatile("s_waitcnt lgkmcnt(0)" ::: "memory");
}

DI void prep_weights(Frame& F, int layer) {
    LAS float* scr = (LAS float*)(F.lds + F.wave * 16384);
    const int gw = F.bid * NWAVES + F.wave, NGW = F.G * NWAVES;
    const float* Win = layer == 0 ? F.in[1] : F.in[3];
    const float* Wout = layer == 0 ? F.in[2] : F.in[4];
    const float* W1 = F.in[8] + (size_t)layer * DM * DFF;
    const float* W2 = F.in[9] + (size_t)layer * DFF * DM;
    const int Nin = layer == 0 ? EVEN_IN : ODD_IN, Npad = layer == 0 ? EVEN_LD : ODD_IN;
    const int nb_in = Npad / 32;
    const int I_IN = (DM / 64) * nb_in, I_OUT = (DM / 64) * (DM / 32), I_1 = (DM / 64) * (DFF / 32), I_2 = (DFF / 64) * (DM / 32);
    const int NIT = I_IN + I_OUT + I_1 + I_2;
    for (int it = gw; it < NIT; it += NGW) {
        int r = it;
        if (r < I_IN) { transpose_item(Win, DM, Nin, (bf16*)(F.ws + WS_WIN), scr, r, nb_in, F.lane); continue; } r -= I_IN;
        if (r < I_OUT) { transpose_item(Wout, DM, DM, (bf16*)(F.ws + WS_WOUT), scr, r, DM / 32, F.lane); continue; } r -= I_OUT;
        if (r < I_1) { transpose_item(W1, DM, DFF, (bf16*)(F.ws + WS_W1), scr, r, DFF / 32, F.lane); continue; } r -= I_1;
        transpose_item(W2, DFF, DM, (bf16*)(F.ws + WS_W2), scr, r, DM / 32, F.lane);
    }
}

DI void prep_misc(Frame& F) {
    const size_t gt = (size_t)F.bid * NTHR + F.tid, NT = (size_t)F.G * NTHR;
    const float* x = F.in[0]; bf16* xb = (bf16*)(F.ws + WS_XB);
#pragma unroll 4
    for (size_t i = gt; i < (size_t)MTOK * DM / 8; i += NT) {
        const f32x4 a = *(const f32x4*)(x + i * 8), b = *(const f32x4*)(x + i * 8 + 4);
        u32x4 o; o.x = cvtpk(a[0], a[1]); o.y = cvtpk(a[2], a[3]); o.z = cvtpk(b[0], b[1]); o.w = cvtpk(b[2], b[3]);
        *(u32x4*)(xb + i * 8) = o;
    }
    const float* rb = F.in[5];
    float* bd = (float*)(F.ws + WS_BIASD);
    for (size_t i = gt; i < 16 * 4096; i += NT) { const int h = (int)(i >> 12), d = (int)(i & 4095); bd[i] = rb[rel_bucket(d) * 16 + h] * LOG2E; }
    if (gt < 64) ((unsigned*)(F.ws + WS_KMAX))[gt] = 0u;
    if (gt < 16) { float bm = -1e30f; for (int k = 0; k < 32; ++k) bm = fmaxf(bm, rb[k * 16 + (int)gt]); ((float*)(F.ws + WS_KMAX + 256))[gt] = bm * LOG2E; }
    float* bdl = (float*)(F.ws + WS_BIASDIL);
    for (size_t i = gt; i < 3 * 16 * 160; i += NT) { const int g = (int)(i / (16 * 160)), rem = (int)(i % (16 * 160)), h = rem / 160, j = rem % 160;
        const int dil = g == 0 ? 1 : (g == 1 ? 4 : 16); const int dist = (j <= 128 ? j : 128) * dil;
        bdl[i] = rb[rel_bucket(dist) * 16 + h] * LOG2E; }
}

DI float wave_sum(float v) {
#pragma unroll
    for (int o = 1; o < 64; o <<= 1) v += __shfl_xor(v, o);
    return v;
}
DI void phase_ln(Frame& F, const float* g, const float* b, bool lazy) {
    const int gw = F.bid * NWAVES + F.wave, NGW = F.G * NWAVES;
    bf16* xb = (bf16*)(F.ws + WS_XB); float* lnst = (float*)(F.ws + WS_LNST);
    f32x4 gv[8], bv[8];
#pragma unroll
    for (int j = 0; j < 8; ++j) { gv[j] = *(const f32x4*)(g + 256 * j + 4 * F.lane); bv[j] = *(const f32x4*)(b + 256 * j + 4 * F.lane); }
    f32x4 vn[8];
    if (gw < MTOK) {
#pragma unroll
        for (int j = 0; j < 8; ++j) vn[j] = *(const f32x4*)(F.out + (size_t)gw * DM + 4 * F.lane + 256 * j); }
    for (int row = gw; row < MTOK; row += NGW) {
        float* xr = F.out + (size_t)row * DM + 4 * F.lane;
        f32x4 v[8]; float s = 0.f;
#pragma unroll
        for (int j = 0; j < 8; ++j) { v[j] = vn[j]; s += (v[j][0] + v[j][1]) + (v[j][2] + v[j][3]); }
        if (row + NGW < MTOK) {
#pragma unroll
            for (int j = 0; j < 8; ++j) vn[j] = *(const f32x4*)(xr + (size_t)NGW * DM + 256 * j); }
        const float mean = wave_sum(s) * (1.f / DM); float s2 = 0.f;
#pragma unroll
        for (int j = 0; j < 8; ++j) { v[j] = v[j] - mean; s2 += (v[j][0] * v[j][0] + v[j][1] * v[j][1]) + (v[j][2] * v[j][2] + v[j][3] * v[j][3]); }
        const float rstd = 1.f / sqrtf(wave_sum(s2) * (1.f / DM) + LN_EPS);
        if (lazy && F.lane == 0) { lnst[2 * row] = mean; lnst[2 * row + 1] = rstd; }
#pragma unroll
        for (int j = 0; j < 8; ++j) { const f32x4 y = v[j] * rstd * gv[j] + bv[j];
            if (lazy) { u32x2 o; o.x = cvtpk(y[0], y[1]); o.y = cvtpk(y[2], y[3]); *(u32x2*)(xb + (size_t)row * DM + 256 * j + 4 * F.lane) = o; }
            else __builtin_nontemporal_store(y, (f32x4*)(xr + 256 * j)); }
    }
}

template <int D> struct RowRegs { u32x4 v[128 * (D / 8) / NTHR]; };
template <int D>
DI void fetch_rows128(RowRegs<D>& R, const bf16* g0, size_t gstride, int tid) {
    constexpr int CPR = D / 8, NCH = 128 * CPR / NTHR;
#pragma unroll
    for (int k = 0; k < NCH; ++k) { const int c = tid + k * NTHR, r = c / CPR, q = c % CPR; R.v[k] = *(const u32x4*)(g0 + (size_t)r * gstride + q * 8); }
}
template <int D, int STR>
DI void put_rows128(LAS unsigned char* dst, const RowRegs<D>& R, int tid) {
    constexpr int CPR = D / 8, NCH = 128 * CPR / NTHR;
#pragma unroll
    for (int k = 0; k < NCH; ++k) { const int c = tid + k * NTHR, r = c / CPR, q = c % CPR; *(LAS u32x4*)(dst + r * STR + q * 16) = R.v[k]; }
}
template <int D, int STR>
DI f32x16 st_tile(LAS const unsigned char* Ks, int krow0, const bf16x8* qf, int tl, int hf) {
    f32x16 x;
#pragma unroll
    for (int i = 0; i < 16; ++i) x[i] = 0.f;
    LAS const unsigned char* kp = Ks + (krow0 + tl) * STR + hf * 16;
#pragma unroll
    for (int st = 0; st < D / 16; ++st) { const bf16x8 kf = *(LAS const bf16x8*)(kp + st * 32); x = MFMA32(kf, qf[st], x); }
    return x;
}
template <int D, int STR>
DI void pv_tile(f32x16* acc, LAS const unsigned char* Vs, int vrow0, bf16x8 p0, bf16x8 p1, int lane) {
    const int hf = lane >> 5, q = (lane & 15) >> 2, p = lane & 3, blk = (lane >> 4) & 1;
    LAS const char* vb = (LAS const char*)Vs + (vrow0 + 4 * hf + q) * STR + blk * 32 + p * 8;
#pragma unroll
    for (int eb = 0; eb < D / 32; ++eb) {
        const s16x4 l0 = vtr(vb + eb * 64), h0 = vtr(vb + 8 * STR + eb * 64);
        const s16x4 l1 = vtr(vb + 16 * STR + eb * 64), h1 = vtr(vb + 24 * STR + eb * 64);
        const bf16x8 v0 = __builtin_shufflevector(l0, h0, 0, 1, 2, 3, 4, 5, 6, 7), v1 = __builtin_shufflevector(l1, h1, 0, 1, 2, 3, 4, 5, 6, 7);
        acc[eb] = MFMA32(v0, p0, acc[eb]); acc[eb] = MFMA32(v1, p1, acc[eb]);
    }
}
template <int D>
DI void store_ot(const f32x16* acc, float inv, bf16* orow, int hf) {
#pragma unroll
    for (int eb = 0; eb < D / 32; ++eb)
#pragma unroll
        for (int k = 0; k < 4; ++k) { u32x2 o; o.x = cvtpk(acc[eb][4 * k] * inv, acc[eb][4 * k + 1] * inv); o.y = cvtpk(acc[eb][4 * k + 2] * inv, acc[eb][4 * k + 3] * inv);
            *(u32x2*)(orow + 32 * eb + 8 * k + 4 * hf) = o; }
}

template <int D, int STR>
DI void load_q_frags(Frame& F, bf16x8* qf, const bf16* g0, size_t gstride, LAS unsigned char* buf) {
    constexpr int CPR = D / 8, NCH = 256 * CPR / NTHR;
    __syncthreads();
    int tid_ = F.tid; asm volatile("" : "+v"(tid_));
#pragma unroll
    for (int hb = 0; hb < NCH; hb += 4) { u32x4 v[4];
#pragma unroll
      for (int k = 0; k < 4; ++k) { const int c = tid_ + (hb + k) * NTHR, r = c / CPR, q = c % CPR; v[k] = *(const u32x4*)(g0 + (size_t)r * gstride + q * 8); }
#pragma unroll
      for (int k = 0; k < 4; ++k) { const int c = tid_ + (hb + k) * NTHR, r = c / CPR, q = c % CPR; *(LAS u32x4*)(buf + r * STR + q * 16) = v[k]; } }
    __syncthreads();
    int lane_ = F.lane; asm volatile("" : "+v"(lane_));
    LAS const unsigned char* qp = buf + (32 * F.wave + (lane_ & 31)) * STR + 16 * (lane_ >> 5);
#pragma unroll
    for (int st = 0; st < D / 16; ++st) qf[st] = *(LAS const bf16x8*)(qp + 32 * st);
}
template <int D, int STR>
DI void store_o_rows(Frame& F, const f32x16* acc, float inv, bf16* o0, size_t gstride, LAS unsigned char* buf) {
    constexpr int CPR = D / 8, NCH = 32 * CPR / 64;
    int lane_ = F.lane; asm volatile("" : "+v"(lane_));
    const int tl = lane_ & 31, hf = lane_ >> 5;
    __syncthreads();
    LAS unsigned char* my = buf + F.wave * 32 * STR;
#pragma unroll
    for (int eb = 0; eb < D / 32; ++eb)
#pragma unroll
        for (int k = 0; k < 4; ++k) { u32x2 o; o.x = cvtpk(acc[eb][4 * k] * inv, acc[eb][4 * k + 1] * inv); o.y = cvtpk(acc[eb][4 * k + 2] * inv, acc[eb][4 * k + 3] * inv);
            *(LAS u32x2*)(my + tl * STR + (32 * eb + 8 * k + 4 * hf) * 2) = o; }
    asm volatile("s_waitcnt lgkmcnt(0)" ::: "memory");
#pragma unroll
    for (int i = 0; i < NCH; ++i) { const int c = lane_ + 64 * i, r = c / CPR, q = c % CPR;
        const u32x4 v = *(LAS const u32x4*)(my + r * STR + q * 16);
        *(u32x4*)(o0 + (size_t)(32 * F.wave + r) * gstride + q * 8) = v; }
}

constexpr int KSTR128 = 272, VSTR128 = 288, KSTR64 = 144, VSTR64 = 144;
constexpr int ATT_K_OFF = 0, ATT_V_OFF = 36864, ATT_TB_OFF = 73728, ATT_FLAG_OFF = 73728 + 16384;

DI void sb_unit(Frame& F, int b, int h, int qb) {
    const bf16* H0 = (const bf16*)(F.ws + WS_BIG); bf16* O = (bf16*)(F.ws + WS_XB);
    LAS unsigned char* Ks = F.lds + ATT_K_OFF; LAS unsigned char* Vs = F.lds + ATT_V_OFF;
    volatile LAS int* flags = (volatile LAS int*)(F.lds + ATT_FLAG_OFF);
    const int lane = F.lane, w = F.wave, tl = lane & 31, hf = lane >> 5;
    const int t0 = 256 * qb, tw = t0 + 32 * w, t = tw + tl;
    __syncthreads();
    if (F.tid < 8) flags[F.tid] = 0;
    bf16x8 qf[8];
    load_q_frags<128, KSTR128>(F, qf, H0 + (size_t)(b * SEQ + t0) * EVEN_LD + C_QA + h * 128, EVEN_LD, Ks);
    f32x16 acc[4];
#pragma unroll
    for (int e = 0; e < 4; ++e)
#pragma unroll
        for (int i = 0; i < 16; ++i) acc[e][i] = 0.f;
    float carry = 0.f; bool wdone = false;
    RowRegs<128> RK, RV;
    const int jtop = (t0 + 255) >> 7;
    { const bf16* kg = H0 + (size_t)(b * SEQ + 128 * jtop) * EVEN_LD + C_KA + h * 128;
      fetch_rows128<128>(RK, kg, EVEN_LD, F.tid); fetch_rows128<128>(RV, kg + (C_VA - C_KA), EVEN_LD, F.tid); }
    for (int j = jtop; j >= 0; --j) {
        __syncthreads();
        { int alld = 1;
#pragma unroll
          for (int k = 0; k < 8; ++k) alld &= flags[k];
          if (alld) break; }
        put_rows128<128, KSTR128>(Ks, RK, F.tid); put_rows128<128, VSTR128>(Vs, RV, F.tid);
        __syncthreads();
        if (j > 0) { const bf16* kg = H0 + (size_t)(b * SEQ + 128 * (j - 1)) * EVEN_LD + C_KA + h * 128;
            fetch_rows128<128>(RK, kg, EVEN_LD, F.tid); fetch_rows128<128>(RV, kg + (C_VA - C_KA), EVEN_LD, F.tid); }
        if (!wdone) {
#pragma unroll 1
            for (int kt = 3; kt >= 0; --kt) {
                const int s0 = 128 * j + 32 * kt;
                if (s0 > tw) continue;
                f32x16 x = st_tile<128, KSTR128>(Ks, 32 * kt, qf, tl, hf);
                float lk[16];
#pragma unroll
                for (int i = 0; i < 16; ++i) {
                    const int s = s0 + crow(i, hf);
                    const float z2 = x[i] * C_D128;
                    const float e = ex2(-fabsf(z2));
                    const float L2 = fmaxf(-z2, 0.f) + lg2(1.f + e);
                    const bool valid = s < t;
                    lk[i] = valid ? (-z2 - L2) : 0.f;
                    x[i] = valid ? -L2 : -1e30f;
                }
                float gs[4], pg[4];
#pragma unroll
                for (int k = 0; k < 4; ++k) { gs[k] = (lk[4 * k] + lk[4 * k + 1]) + (lk[4 * k + 2] + lk[4 * k + 3]); pg[k] = swap_other(gs[k], hf); }
                float above[4];
                { float run = 0.f;
#pragma unroll
                  for (int k = 3; k >= 0; --k) { above[k] = run + (hf == 0 ? pg[k] : 0.f); run += gs[k] + pg[k]; }
                  const float base = carry; carry += run;
#pragma unroll
                  for (int k = 0; k < 4; ++k) {
                      const float a3 = base + above[k];
                      const float a2 = a3 + lk[4 * k + 3], a1 = a2 + lk[4 * k + 2], a0 = a1 + lk[4 * k + 1];
                      x[4 * k + 3] = ex2(x[4 * k + 3] + a3); x[4 * k + 2] = ex2(x[4 * k + 2] + a2);
                      x[4 * k + 1] = ex2(x[4 * k + 1] + a1); x[4 * k] = ex2(x[4 * k] + a0);
                  } }
                const bf16x8 p0 = pack8(x, 0), p1 = pack8(x, 1);
                pv_tile<128, VSTR128>(acc, Vs, 32 * kt, p0, p1, lane);
            }
            wdone = __all(carry < -200.f);
            if (wdone && lane == 0) flags[w] = 1;
        }
    }
    store_o_rows<128, KSTR128>(F, acc, 1.f, O + (size_t)(b * SEQ + t0) * DM + h * 128, DM, Ks);
}

DI float bfi_f(unsigned m, float a, float b) { return __uint_as_float((__float_as_uint(a) & m) | (__float_as_uint(b) & ~m)); }
DI void dsa_unit(Frame& F, int b, int h, int qb) {
    const bf16* H0 = (const bf16*)(F.ws + WS_BIG); bf16* O = (bf16*)(F.ws + WS_XB);
    const unsigned* mask = (const unsigned*)(F.ws + WS_MASK);
    LAS unsigned char* Ks = F.lds + ATT_K_OFF; LAS unsigned char* Vs = F.lds + ATT_V_OFF;
    LAS float* tb = (LAS float*)(F.lds + ATT_TB_OFF);
    const int lane = F.lane, w = F.wave, tl = lane & 31, hf = lane >> 5;
    const int t0 = 256 * qb, tw = t0 + 32 * w, t = tw + tl;
    __syncthreads();
    { const float* bd = (const float*)(F.ws + WS_BIASD) + h * 4096;
      for (int i = F.tid; i < 4096; i += NTHR) tb[4095 - i] = bd[i]; }
    bf16x8 qf[4];
    load_q_frags<64, KSTR64>(F, qf, H0 + (size_t)(b * SEQ + t0) * EVEN_LD + C_QB + h * 64, EVEN_LD, Ks);
    f32x16 acc[2];
#pragma unroll
    for (int e = 0; e < 2; ++e)
#pragma unroll
        for (int i = 0; i < 16; ++i) acc[e][i] = 0.f;
    float S;
    { float qn = 0.f;
#pragma unroll
      for (int st = 0; st < 4; ++st)
#pragma unroll
          for (int q = 0; q < 8; ++q) { const float v = __uint_as_float(((unsigned)(unsigned short)qf[st][q]) << 16); qn += v * v; }
      qn = swap_sum(qn);
      const float k2 = __uint_as_float(((const unsigned*)(F.ws + WS_KMAX))[b * 16 + h]);
      const float U = sqrtf(qn * k2) * C_D64 * 1.001f + ((const float*)(F.ws + WS_KMAX + 256))[h] + 0.01f;
      S = fmaxf(U - 100.f, 0.f); }
    const bool noshift = __all(S == 0.f);
    float l = 0.f;
    const unsigned* mrow = mask + (size_t)(b * SEQ + t) * 128;
    const int jmax = (t0 + 255) >> 7;
    RowRegs<64> RK, RV;
    { const bf16* kg = H0 + (size_t)(b * SEQ) * EVEN_LD + C_KB + h * 64;
      fetch_rows128<64>(RK, kg, EVEN_LD, F.tid); fetch_rows128<64>(RV, kg + (C_VB - C_KB), EVEN_LD, F.tid); }
    u32x4 mwn = *(const u32x4*)(mrow);
    for (int j = 0; j <= jmax; ++j) {
        __syncthreads();
        put_rows128<64, KSTR64>(Ks, RK, F.tid); put_rows128<64, VSTR64>(Vs, RV, F.tid);
        const u32x4 mw4 = mwn;
        __syncthreads();
        if (j < jmax) { const bf16* kg = H0 + (size_t)(b * SEQ + 128 * (j + 1)) * EVEN_LD + C_KB + h * 64;
            fetch_rows128<64>(RK, kg, EVEN_LD, F.tid); fetch_rows128<64>(RV, kg + (C_VB - C_KB), EVEN_LD, F.tid);
            mwn = *(const u32x4*)(mrow + 4 * (j + 1)); }
#pragma unroll
        for (int kt = 0; kt < 4; ++kt) {
            const int s0 = 128 * j + 32 * kt;
            if (s0 > tw + 31) continue;
            const unsigned mws = mw4[kt] >> (4 * hf);
            f32x16 x = st_tile<64, KSTR64>(Ks, 32 * kt, qf, tl, hf);
            const LAS float* tp = tb + (4095 - (t - s0 - 4 * hf));
            if (noshift) {
#pragma unroll
                for (int i = 0; i < 16; ++i) {
                    const int ci = (i & 3) + 8 * (i >> 2);
                    const unsigned mm = (unsigned)__builtin_amdgcn_sbfe((int)mws, ci, 1);
                    x[i] = ex2(bfi_f(mm, x[i] * C_D64 + tp[ci], -INFINITY));
                    l += x[i];
                }
            } else {
#pragma unroll
                for (int i = 0; i < 16; ++i) {
                    const int ci = (i & 3) + 8 * (i >> 2);
                    const unsigned mm = (unsigned)__builtin_amdgcn_sbfe((int)mws, ci, 1);
                    x[i] = ex2(bfi_f(mm, x[i] * C_D64 + tp[ci], -INFINITY) - S);
                    l += x[i];
                }
            }
            const bf16x8 p0 = pack8(x, 0), p1 = pack8(x, 1);
            pv_tile<64, VSTR64>(acc, Vs, 32 * kt, p0, p1, lane);
        }
    }
    l = swap_sum(l);
    store_o_rows<64, KSTR64>(F, acc, 1.f / l, O + (size_t)(b * SEQ + t0) * DM + 1024 + h * 64, DM, Ks);
}

DI void store_o_rows_merge(Frame& F, const f32x16* acc, float m0v, float l0v, bf16* out0, const bf16* o1, const bf16* o2, const float* st, size_t tok0, int h, LAS unsigned char* buf) {
    constexpr int STR = KSTR128;
    int lane_ = F.lane; asm volatile("" : "+v"(lane_));
    const int tl = lane_ & 31, hf = lane_ >> 5;
    const float inv0 = 1.f / l0v;
    __syncthreads();
    LAS unsigned char* my = buf + F.wave * 32 * STR;
    LAS float* ml = (LAS float*)(buf + 8 * 32 * STR + F.wave * 256);
#pragma unroll
    for (int eb = 0; eb < 4; ++eb)
#pragma unroll
        for (int k = 0; k < 4; ++k) { u32x2 o; o.x = cvtpk(acc[eb][4 * k] * inv0, acc[eb][4 * k + 1] * inv0); o.y = cvtpk(acc[eb][4 * k + 2] * inv0, acc[eb][4 * k + 3] * inv0);
            *(LAS u32x2*)(my + tl * STR + (32 * eb + 8 * k + 4 * hf) * 2) = o; }
    if (hf == 0) { ml[2 * tl] = m0v; ml[2 * tl + 1] = l0v; }
    asm volatile("s_waitcnt lgkmcnt(0)" ::: "memory");
#pragma unroll
    for (int hb = 0; hb < 8; hb += 4) {
        u32x4 bq[4], cq[4]; float m1[4], s1[4], m2[4], s2[4];
#pragma unroll
        for (int k = 0; k < 4; ++k) { const int c = lane_ + 64 * (hb + k), r = c >> 4, q = c & 15;
            const size_t tok = tok0 + 32 * F.wave + r, off = tok * DM + h * 128 + q * 8, si = tok * 16 + h;
            bq[k] = *(const u32x4*)(o1 + off); cq[k] = *(const u32x4*)(o2 + off);
            m1[k] = st[(size_t)2 * MTOK * 16 + si]; s1[k] = st[(size_t)3 * MTOK * 16 + si]; m2[k] = st[(size_t)4 * MTOK * 16 + si]; s2[k] = st[(size_t)5 * MTOK * 16 + si]; }
#pragma unroll
        for (int k = 0; k < 4; ++k) { const int c = lane_ + 64 * (hb + k), r = c >> 4, q = c & 15;
            const u32x4 a = *(LAS const u32x4*)(my + r * STR + q * 16);
            const size_t off = (tok0 + 32 * F.wave + r) * DM + h * 128 + q * 8;
            const float m0 = ml[2 * r], s0 = ml[2 * r + 1];
            const float mm = fmaxf(m0, fmaxf(m1[k], m2[k]));
            float w0 = s0 * ex2(m0 - mm), w1 = s1[k] * ex2(m1[k] - mm), w2 = s2[k] * ex2(m2[k] - mm);
            const float inv = 1.f / (w0 + w1 + w2); w0 *= inv; w1 *= inv; w2 *= inv;
            u32x4 o;
#pragma unroll
            for (int e = 0; e < 4; ++e) {
                const unsigned ua = a[e], ub = bq[k][e], uc = cq[k][e];
                const float lo = w0 * __uint_as_float(ua << 16) + w1 * __uint_as_float(ub << 16) + w2 * __uint_as_float(uc << 16);
                const float hi = w0 * __uint_as_float(ua & 0xffff0000u) + w1 * __uint_as_float(ub & 0xffff0000u) + w2 * __uint_as_float(uc & 0xffff0000u);
                o[e] = cvtpk(lo, hi); }
            *(u32x4*)(out0 + off) = o; }
    }
}

struct DilItem { int g, b, h, r, nb; };
DI DilItem dil_item(int k) {
    DilItem it; int bh, sub;
    if (k < 1024) { it.g = 0; bh = k >> 4; sub = k & 15; }
    else { const int idx = k - 1024; bh = idx >> 5; it.g = 1 + ((idx >> 4) & 1); sub = idx & 15; }
    const int d = it.g == 0 ? 1 : (it.g == 1 ? 4 : 16), nbk = 16 / d;
    it.b = bh >> 4; it.h = bh & 15; it.r = sub / nbk; it.nb = sub % nbk; return it;
}
DI const bf16* dil_hm(Frame& F, int which, int b, int h, int pos) { return (const bf16*)(F.ws + WS_BIG) + (size_t)which * MTOK * 2048 + ((size_t)(b * 16 + h) * SEQ + pos) * 128; }
DI const bf16* dil_kptr(Frame& F, const DilItem& it, int st, size_t& gstr) {
    const int d = it.g == 0 ? 1 : (it.g == 1 ? 4 : 16); gstr = (size_t)d * 128;
    return dil_hm(F, 1, it.b, it.h, (256 * it.nb - 128 + 128 * st) * d + it.r);
}
DI void dil_unit(Frame& F, const DilItem& it, bool has_next, const DilItem& nx, RowRegs<128>& RK, RowRegs<128>& RV) {
    const int g = it.g, b = it.b, h = it.h, r = it.r, nb = it.nb;
    const bf16* H1 = (const bf16*)(F.ws + WS_BIG);
    bf16* O = g == 0 ? (bf16*)(F.ws + WS_XB) : (bf16*)(F.ws + WS_OG) + (size_t)(g - 1) * MTOK * DM;
    float* stM = (float*)(F.ws + WS_STAT) + (size_t)(2 * g) * MTOK * 16; float* stS = stM + (size_t)MTOK * 16;
    LAS unsigned char* Ks = F.lds + ATT_K_OFF; LAS unsigned char* Vs = F.lds + ATT_V_OFF;
    LAS float* tb = (LAS float*)(F.lds + ATT_TB_OFF);
    const int lane = F.lane, w = F.wave, tl = lane & 31, hf = lane >> 5;
    const int d = g == 0 ? 1 : (g == 1 ? 4 : 16);
    const int m0 = 256 * nb, iq = 32 * w + tl;
    const size_t tokq = (size_t)b * SEQ + (size_t)(m0 + iq) * d + r;
    __syncthreads();
    { const float* bd = (const float*)(F.ws + WS_BIASDIL) + (g * 16 + h) * 160;
      if (F.tid <= 128) tb[128 - F.tid] = bd[F.tid]; }
    bf16x8 qf[8];
    const size_t tok0 = (size_t)b * SEQ + (size_t)m0 * d + r;
    load_q_frags<128, KSTR128>(F, qf, dil_hm(F, 0, b, h, m0 * d + r), (size_t)d * 128, Ks);
    f32x16 acc[4];
#pragma unroll
    for (int e = 0; e < 4; ++e)
#pragma unroll
        for (int i = 0; i < 16; ++i) acc[e][i] = 0.f;
    float m = -1e30f, l = 0.f;
    const int st_lo = (nb == 0 ? 1 : 0);
    for (int st = st_lo; st < 3; ++st) {
        const int cbase = -128 + 128 * st;
        __syncthreads();
        put_rows128<128, KSTR128>(Ks, RK, F.tid); put_rows128<128, VSTR128>(Vs, RV, F.tid);
        __syncthreads();
        if (st < 2) { size_t gs; const bf16* kg = dil_kptr(F, it, st + 1, gs);
            fetch_rows128<128>(RK, kg, gs, F.tid); fetch_rows128<128>(RV, kg + (size_t)MTOK * 2048, gs, F.tid); }
        else if (has_next) { size_t gs; const bf16* kg = dil_kptr(F, nx, nx.nb == 0 ? 1 : 0, gs);
            fetch_rows128<128>(RK, kg, gs, F.tid); fetch_rows128<128>(RV, kg + (size_t)MTOK * 2048, gs, F.tid); }
#pragma unroll 1
        for (int kt = 0; kt < 4; ++kt) {
            const int c0 = cbase + 32 * kt;
            const int delta = 32 * w - c0;
            if (delta < 0 || delta > 128) continue;
            f32x16 x = st_tile<128, KSTR128>(Ks, 32 * kt, qf, tl, hf);
            const int jb = iq - c0 - 4 * hf;
            float mx = -1e30f;
            if (delta == 0 || delta == 128) {
                const unsigned mword = delta == 0 ? (0xffffffffu >> (31 - tl)) : (0xffffffffu << tl);
                const unsigned mws = mword >> (4 * hf);
                const LAS float* tp = tb + (128 - jb);
#pragma unroll
                for (int i = 0; i < 16; ++i) {
                    const int ci = (i & 3) + 8 * (i >> 2);
                    const unsigned mm = (unsigned)__builtin_amdgcn_sbfe((int)mws, ci, 1);
                    x[i] = bfi_f(mm, x[i] * C_D128 + tp[ci], -INFINITY);
                    mx = fmaxf(mx, x[i]);
                }
            } else {
                const LAS float* tp = tb + (128 - jb);
#pragma unroll
                for (int i = 0; i < 16; ++i) { const int ci = (i & 3) + 8 * (i >> 2); x[i] = x[i] * C_D128 + tp[ci]; mx = fmaxf(mx, x[i]); }
            }
            mx = swap_max(mx);
            const float mn = (mx > m + 8.f) ? mx : m, alpha = ex2(m - mn);
            float ps = 0.f;
#pragma unroll
            for (int i = 0; i < 16; ++i) { x[i] = ex2(x[i] - mn); ps += x[i]; }
            ps = swap_sum(ps);
            l = l * alpha + ps; m = mn;
            if (!__all(alpha == 1.f)) {
#pragma unroll
                for (int e = 0; e < 4; ++e)
#pragma unroll
                    for (int i = 0; i < 16; ++i) acc[e][i] *= alpha;
            }
            const bf16x8 p0 = pack8(x, 0), p1 = pack8(x, 1);
            pv_tile<128, VSTR128>(acc, Vs, 32 * kt, p0, p1, lane);
        }
    }
    if (g == 0) {
        store_o_rows_merge(F, acc, m, l, (bf16*)(F.ws + WS_XB), (const bf16*)(F.ws + WS_OG), (const bf16*)(F.ws + WS_OG) + (size_t)MTOK * DM, (const float*)(F.ws + WS_STAT), tok0, h, Ks);
    } else {
        store_o_rows<128, KSTR128>(F, acc, 1.f / l, O + tok0 * DM + h * 128, (size_t)d * DM, Ks);
        if (hf == 0) { stM[tokq * 16 + h] = m; stS[tokq * 16 + h] = l; }
    }
}

DI void phase_merge(Frame& F) {
    const int gw = F.bid * NWAVES + F.wave, NGW = F.G * NWAVES;
    bf16* o0 = (bf16*)(F.ws + WS_XB); const bf16* o1 = (const bf16*)(F.ws + WS_OG); const bf16* o2 = o1 + (size_t)MTOK * DM;
    const float* st = (const float*)(F.ws + WS_STAT);
    const int h = F.lane >> 2;
    for (int row = gw; row < MTOK; row += NGW) {
        const size_t si = (size_t)row * 16 + h, off = (size_t)row * DM + 32 * F.lane;
        u32x4 a[4], bq[4], c[4];
#pragma unroll
        for (int j = 0; j < 4; ++j) { a[j] = *(const u32x4*)(o0 + off + 8 * j); bq[j] = *(const u32x4*)(o1 + off + 8 * j); c[j] = *(const u32x4*)(o2 + off + 8 * j); }
        const float m0 = st[si], s0 = st[(size_t)MTOK * 16 + si], m1 = st[(size_t)2 * MTOK * 16 + si], s1 = st[(size_t)3 * MTOK * 16 + si],
                    m2 = st[(size_t)4 * MTOK * 16 + si], s2 = st[(size_t)5 * MTOK * 16 + si];
        const float mm = fmaxf(m0, fmaxf(m1, m2));
        float w0 = s0 * ex2(m0 - mm), w1 = s1 * ex2(m1 - mm), w2 = s2 * ex2(m2 - mm);
        const float inv = 1.f / (w0 + w1 + w2); w0 *= inv; w1 *= inv; w2 *= inv;
#pragma unroll
        for (int j = 0; j < 4; ++j) { u32x4 o;
#pragma unroll
            for (int q = 0; q < 4; ++q) {
                const unsigned ua = a[j][q], ub = bq[j][q], uc = c[j][q];
                const float lo = w0 * __uint_as_float(ua << 16) + w1 * __uint_as_float(ub << 16) + w2 * __uint_as_float(uc << 16);
                const float hi = w0 * __uint_as_float(ua & 0xffff0000u) + w1 * __uint_as_float(ub & 0xffff0000u) + w2 * __uint_as_float(uc & 0xffff0000u);
                o[q] = cvtpk(lo, hi); }
            *(u32x4*)(o0 + off + 8 * j) = o; }
    }
}

DI void phase_kmax(Frame& F) {
    const bf16* H0 = (const bf16*)(F.ws + WS_BIG); unsigned* kmax = (unsigned*)(F.ws + WS_KMAX);
    const int gw = F.bid * NWAVES + F.wave, NGW = F.G * NWAVES;
    for (int r8 = gw; r8 < MTOK / 8; r8 += NGW) {
        float best = 0.f;
#pragma unroll
        for (int k = 0; k < 8; ++k) {
            const bf16* p = H0 + (size_t)(r8 * 8 + k) * EVEN_LD + C_KB + 16 * F.lane;
            const u32x4 a = *(const u32x4*)p, b = *(const u32x4*)(p + 8);
            float ssq = 0.f;
#pragma unroll
            for (int q = 0; q < 4; ++q) { const float a0 = __uint_as_float(a[q] << 16), a1 = __uint_as_float(a[q] & 0xffff0000u), b0 = __uint_as_float(b[q] << 16), b1 = __uint_as_float(b[q] & 0xffff0000u);
                ssq += (a0 * a0 + a1 * a1) + (b0 * b0 + b1 * b1); }
            ssq += __shfl_xor(ssq, 1); ssq += __shfl_xor(ssq, 2);
            best = fmaxf(best, ssq);
        }
        if ((F.lane & 3) == 0) atomicMax(kmax + ((r8 * 8) >> 12) * 16 + (F.lane >> 2), __float_as_uint(best));
    }
}

DI int row_sum16(int x) {
    x += __builtin_amdgcn_update_dpp(0, x, 0xB1, 0xF, 0xF, true);
    x += __builtin_amdgcn_update_dpp(0, x, 0x4E, 0xF, 0xF, true);
    x += __builtin_amdgcn_update_dpp(0, x, 0x141, 0xF, 0xF, true);
    x += __builtin_amdgcn_update_dpp(0, x, 0x140, 0xF, 0xF, true);
    return x;
}
DI int wave_sum_i(int x) { x = row_sum16(x); return __builtin_amdgcn_readlane(x, 0) + __builtin_amdgcn_readlane(x, 16) + __builtin_amdgcn_readlane(x, 32) + __builtin_amdgcn_readlane(x, 48); }
DI int cnt4_ge(unsigned k0, unsigned k1, unsigned k2, unsigned k3, unsigned cand, int cl) {
    unsigned long long m0, m1, m2, m3;
    asm volatile("v_cmp_le_u32_e64 %1, %9, %5\n\tv_cmp_le_u32_e64 %2, %9, %6\n\tv_cmp_le_u32_e64 %3, %9, %7\n\tv_cmp_le_u32_e64 %4, %9, %8\n\t"
                 "v_addc_co_u32_e64 %0, %1, 0, %0, %1\n\tv_addc_co_u32_e64 %0, %2, 0, %0, %2\n\tv_addc_co_u32_e64 %0, %3, 0, %0, %3\n\tv_addc_co_u32_e64 %0, %4, 0, %0, %4"
                 : "+v"(cl), "=&s"(m0), "=&s"(m1), "=&s"(m2), "=&s"(m3) : "v"(k0), "v"(k1), "v"(k2), "v"(k3), "s"(cand));
    return cl;
}
DI unsigned f2ord(float f) { const unsigned u = __float_as_uint(f); return (u & 0x80000000u) ? ~u : (u | 0x80000000u); }
DI void index_unit(Frame& F, int b, int t0) {
    const bf16* H0 = (const bf16*)(F.ws + WS_BIG);
    unsigned long long* mask64 = (unsigned long long*)(F.ws + WS_MASK);
    LAS float* sc = (LAS float*)F.lds;
    const int lane = F.lane, w = F.wave, r = lane & 31, hf = lane >> 5;
    __syncthreads();
    const int rg = r >> 3, rhh = (r >> 2) & 1, rc = r & 3, a_tq = 2 * rhh + (rg >> 1), a_hd = 4 * (rg & 1) + rc;
    bf16x8 qa[2][4]; float wv[2][16];
#pragma unroll
    for (int mt = 0; mt < 2; ++mt) {
        const bf16* qp = H0 + (size_t)(b * SEQ + t0 + 4 * mt + a_tq) * EVEN_LD + C_QI + a_hd * 64 + 8 * hf;
#pragma unroll
        for (int st = 0; st < 4; ++st) qa[mt][st] = *(const bf16x8*)(qp + 16 * st);
#pragma unroll
        for (int q = 0; q < 2; ++q) {
            const bf16* wp = H0 + (size_t)(b * SEQ + t0 + 4 * mt + 2 * hf + q) * EVEN_LD + C_WI;
            const u32x4 wr = *(const u32x4*)wp;
#pragma unroll
            for (int k = 0; k < 4; ++k) { const unsigned u = wr[k]; wv[mt][8 * q + 2 * k] = bf2f((unsigned short)(u & 0xffff)) * 0.04419417382415922f; wv[mt][8 * q + 2 * k + 1] = bf2f((unsigned short)(u >> 16)) * 0.04419417382415922f; }
        }
    }
    const int nkt = (t0 + 8 + 31) >> 5;
    if (t0 + 8 > 256) for (int _r22 = 0; _r22 < (PROBE_PHASE == 22 ? 2 : 1); ++_r22) {
        bf16x8 kb[4], kn[4];
        { const bf16* kp = H0 + (size_t)(b * SEQ + 32 * w + r) * EVEN_LD + C_KI + 8 * hf;
          if (w < nkt) {
#pragma unroll
              for (int st = 0; st < 4; ++st) kb[st] = *(const bf16x8*)(kp + 16 * st); } }
        for (int kt = w; kt < nkt; kt += NWAVES) {
            const int s = 32 * kt + r;
            if (kt + NWAVES < nkt) { const bf16* kp = H0 + (size_t)(b * SEQ + s + 32 * NWAVES) * EVEN_LD + C_KI + 8 * hf;
#pragma unroll
                for (int st = 0; st < 4; ++st) kn[st] = *(const bf16x8*)(kp + 16 * st); }
#pragma unroll
            for (int mt = 0; mt < 2; ++mt) {
                f32x16 x;
#pragma unroll
                for (int i = 0; i < 16; ++i) x[i] = 0.f;
#pragma unroll
                for (int st = 0; st < 4; ++st) x = MFMA32(qa[mt][st], kb[st], x);
                float s0v = 0.f, s1v = 0.f;
#pragma unroll
                for (int i = 0; i < 8; ++i) { s0v += wv[mt][i] * fmaxf(x[i], 0.f); s1v += wv[mt][8 + i] * fmaxf(x[8 + i], 0.f); }
                const int tq0 = 4 * mt + 2 * hf;
                sc[tq0 * 4096 + s] = (s <= t0 + tq0) ? (s0v + 0.f) : -1e30f;
                sc[(tq0 + 1) * 4096 + s] = (s <= t0 + tq0 + 1) ? (s1v + 0.f) : -1e30f;
            }
#pragma unroll
            for (int st = 0; st < 4; ++st) kb[st] = kn[st];
        }
    }
    __syncthreads();
    const int t = t0 + w;
    unsigned long long myword = 0ull;
    for (int _r21 = 0; _r21 < (PROBE_PHASE == 21 ? 2 : 1); ++_r21)
    if (t < 256) {
        const int nbits = t + 1 - 64 * lane;
        myword = nbits >= 64 ? ~0ull : (nbits <= 0 ? 0ull : ((1ull << nbits) - 1ull));
    } else {
        unsigned key[64];
#pragma unroll
        for (int i = 0; i < 64; ++i) { const int s = 64 * i + lane; key[i] = (s <= t) ? f2ord(sc[w * 4096 + s]) : 0u; }
        unsigned res = 0u;
        const int nreg = (t >> 6) + 1;
#pragma unroll 1
        for (int bit = 31; bit >= 0; --bit) {
            const unsigned cand = res | (1u << bit);
            int cl = 0;
#pragma unroll
            for (int gq = 0; gq < 8; ++gq) if (8 * gq < nreg) {
#pragma unroll
                for (int i = 8 * gq; i < 8 * gq + 8; i += 4) cl = cnt4_ge(key[i], key[i + 1], key[i + 2], key[i + 3], cand, cl); }
            const int cnt = wave_sum_i(cl);
            if (cnt >= 256) { res = cand; if (cnt == 256) break; }
        }
        int need, eqc;
        { int cg_ = 0, ce_ = 0;
#pragma unroll
          for (int gq = 0; gq < 8; ++gq) if (8 * gq < nreg) {
#pragma unroll
              for (int i = 8 * gq; i < 8 * gq + 8; ++i) { cg_ += (key[i] > res) ? 1 : 0; ce_ += (key[i] == res) ? 1 : 0; } }
          need = 256 - wave_sum_i(cg_); eqc = wave_sum_i(ce_); }
        if (eqc == need) {
#pragma unroll
            for (int i = 0; i < 64; ++i) { const unsigned long long sb = __ballot(key[i] >= res);
                if (lane == i) myword = sb; }
        } else {
            const unsigned long long lt = (1ull << lane) - 1ull;
            int running = 0;
#pragma unroll
            for (int i = 0; i < 64; ++i) {
                const bool gtb = key[i] > res, eq = key[i] == res;
                const unsigned long long tbm = __ballot(eq);
                const int rank = running + __popcll(tbm & lt);
                const unsigned long long sb = __ballot(gtb || (eq && rank < need));
                if (lane == i) myword = sb;
                running += __popcll(tbm);
            }
        }
    }
    mask64[(size_t)(b * SEQ + t) * 64 + lane] = myword;
}

#define SNAKE_FOR(NITEMS, k) for (int _rd = 0, k; _rd * F.G < (NITEMS); ++_rd) if ((k = (_rd & 1) ? _rd * F.G + (F.G - 1 - F.bid) : _rd * F.G + F.bid) < (NITEMS))

#define XB_TMO      128
#define XB_XCNT(j)  (256  + 64 * (j))
#define XB_XSUB(j)  (1280 + 64 * (j))
#define XB_XGEN(j)  (2304 + 64 * (j))
#define XB_TOP      3328
#define XB_TOPGEN   3392
#define XCD_BAR_WORDS 3456
#define XB_SPIN_CAP (1u << 18)

__device__ __forceinline__ unsigned xb_ld(unsigned* p)              { return __hip_atomic_load(p, __ATOMIC_RELAXED, __HIP_MEMORY_SCOPE_AGENT); }
__device__ __forceinline__ unsigned xb_add(unsigned* p, unsigned v) { return __hip_atomic_fetch_add(p, v, __ATOMIC_RELAXED, __HIP_MEMORY_SCOPE_AGENT); }
__device__ __forceinline__ unsigned xb_xcc_id() { return (unsigned)__builtin_amdgcn_s_getreg((3 << 11) | 20) & 0xFu; }
#define XB_SPIN(cond, bar) do { unsigned _sp = 0; while (cond) { __builtin_amdgcn_s_sleep(1); \
    if ((++_sp & 255u) == 0u) { if (xb_ld(&(bar)[XB_TMO])) break; if (_sp > XB_SPIN_CAP) { atomicAdd(&(bar)[XB_TMO], 1u); break; } } } } while (0)

struct XcdBarrier {
    unsigned* bar; unsigned x;
    volatile LAS unsigned* st;
};

__device__ __forceinline__ XcdBarrier xcd_barrier_post(unsigned* bar, volatile LAS unsigned* st) {
    XcdBarrier b; b.bar = bar; b.x = xb_xcc_id(); b.st = st;
    if (threadIdx.x == 0) (void)xb_add(&bar[XB_XCNT(b.x)], 1u);
    return b;
}
__device__ __forceinline__ void xcd_barrier_complete(unsigned* bar, unsigned x, unsigned& nloc, unsigned& nx) {
    const unsigned G = gridDim.x * gridDim.y * gridDim.z;
    unsigned sum, cnt, mine, sp = 0u;
    for (;;) {
        sum = 0u; cnt = 0u; mine = 0u;
#pragma unroll
        for (unsigned j = 0; j < 16; ++j) { const unsigned c = xb_ld(&bar[XB_XCNT(j)]); sum += c; cnt += (c > 0u) ? 1u : 0u; mine = (j == x) ? c : mine; }
        if (sum == G) break;
        __builtin_amdgcn_s_sleep(1);
        if ((++sp & 255u) == 0u) { if (xb_ld(&bar[XB_TMO])) break; if (sp > XB_SPIN_CAP) { atomicAdd(&bar[XB_TMO], 1u); break; } }
    }
    nloc = mine > 0u ? mine : 1u; nx = cnt > 0u ? cnt : 1u;
}

__device__ __forceinline__ void xcd_barrier(const XcdBarrier& b) {
    asm volatile("s_waitcnt vmcnt(0)" ::: "memory");
    __syncthreads();
    if (threadIdx.x == 0) {
        unsigned* bar = b.bar;
        __builtin_amdgcn_s_waitcnt(0);
        unsigned nloc = b.st[0], nx = b.st[1];
        if (nloc == 0u) { xcd_barrier_complete(bar, b.x, nloc, nx); b.st[0] = nloc; b.st[1] = nx; }
        const unsigned old = xb_add(&bar[XB_XSUB(b.x)], 1u);
        const unsigned gen = old / nloc;
        if (old + 1u == (gen + 1u) * nloc) {
            __builtin_amdgcn_fence(__ATOMIC_RELEASE, "agent");
            asm volatile("s_waitcnt vmcnt(0)" ::: "memory");
            const unsigned og = xb_add(&bar[XB_TOP], 1u);
            const unsigned tg = og / nx;
            if (og + 1u == (tg + 1u) * nx) xb_add(&bar[XB_TOPGEN], 1u);
            else XB_SPIN(xb_ld(&bar[XB_TOPGEN]) == tg, bar);
            __builtin_amdgcn_fence(__ATOMIC_ACQUIRE, "agent");
            xb_add(&bar[XB_XGEN(b.x)], 1u);
            asm volatile("s_waitcnt vmcnt(0)" ::: "memory");
        } else {
            XB_SPIN(xb_ld(&bar[XB_XGEN(b.x)]) == gen, bar);
            __builtin_amdgcn_fence(__ATOMIC_ACQUIRE, "agent");
            asm volatile("s_waitcnt vmcnt(0)" ::: "memory");
        }
    }
    __syncthreads();
}

struct Args { const float* in[12]; float* out; unsigned char* ws; int ph_lo, ph_hi; };

DI void gemm_bf16(Frame& F, const bf16* A, const bf16* Bt, int N, int K, bf16* O, int ldc, bool sq) {
    pg8::Gemm g{A, Bt, MTOK, N, K}; pg8::StaticOrder S; S.init(MTOK, N, F.G, F.bid);
    if (sq) { pg8::EpiBf16<2> E{O, ldc}; pg8::gemm_phase<pg8::EpiBf16<2>, pg8::StaticOrder, PG8_ALIGN, PG8_SP2>((PG8_LAS unsigned char*)F.lds, g, S, E); }
    else { pg8::EpiBf16<0> E{O, ldc}; pg8::gemm_phase<pg8::EpiBf16<0>, pg8::StaticOrder, PG8_ALIGN, PG8_SP2>((PG8_LAS unsigned char*)F.lds, g, S, E); }
}
DI void gemm_res_ln(Frame& F, const bf16* A, const bf16* Bt, int K, float* out, const float* g, const float* b) {
    pg8::Gemm gm{A, Bt, MTOK, DM, K}; pg8::StaticOrder S; S.init(MTOK, DM, F.G, F.bid);
    pg8::EpiResLnF32 E{out, out, DM, DN_ALPHA, (const float*)(F.ws + WS_LNST), g, b};
    pg8::gemm_phase<pg8::EpiResLnF32, pg8::StaticOrder, PG8_ALIGN, PG8_SP2>((PG8_LAS unsigned char*)F.lds, gm, S, E);
}
DI void gemm_res(Frame& F, const bf16* A, const bf16* Bt, int K, const float* res, float* out) {
    pg8::Gemm g{A, Bt, MTOK, DM, K}; pg8::StaticOrder S; S.init(MTOK, DM, F.G, F.bid);
    pg8::EpiResF32 E{res, out, DM, DN_ALPHA};
    pg8::gemm_phase<pg8::EpiResF32, pg8::StaticOrder, PG8_ALIGN, PG8_SP2>((PG8_LAS unsigned char*)F.lds, g, S, E);
}

__global__ void __launch_bounds__(NTHR, 2) fwd(Args args) {
    extern __shared__ __attribute__((aligned(16))) unsigned char lds_raw[];
    Frame F;
    F.lds = (LAS unsigned char*)lds_raw;
    F.tid = threadIdx.x; F.lane = F.tid & 63; F.wave = __builtin_amdgcn_readfirstlane(F.tid >> 6);
    F.G = gridDim.x; F.bid = blockIdx.x;
#pragma unroll
    for (int i = 0; i < 12; ++i) F.in[i] = args.in[i];
    F.out = args.out; F.ws = args.ws;
    unsigned char* ws = args.ws;
    bf16* XB = (bf16*)(ws + WS_XB); bf16* BIG = (bf16*)(ws + WS_BIG);
    const bf16* WIN = (const bf16*)(ws + WS_WIN); const bf16* WOUT = (const bf16*)(ws + WS_WOUT);
    const bf16* W1 = (const bf16*)(ws + WS_W1); const bf16* W2 = (const bf16*)(ws + WS_W2);
    const int lo = args.ph_lo, hi = args.ph_hi;
#define IN(k) (lo <= (k) && (k) < hi)
#define SEAM(k) do { if (IN(k) && IN((k) + 1)) { xcd_barrier(bar); } } while (0)
    volatile LAS unsigned* MISC = (volatile LAS unsigned*)(F.lds + 131072 + 64);
    unsigned* barw = (unsigned*)ws;
    if (F.tid < 4) MISC[F.tid] = 0u;
    __syncthreads();
    XcdBarrier bar; bar.bar = barw; bar.x = 0; bar.st = MISC;
    if (hi - lo > 1) bar = xcd_barrier_post(barw, MISC);
    if (lo == 0x7fffffff) cg::this_grid().sync();

    if (IN(0)) REPS(0) { prep_weights(F, 0); prep_misc(F); } SEAM(0);
    if (IN(1)) { gemm_bf16(F, XB, WIN, EVEN_LD, DM, BIG, EVEN_LD, false); if (PROBE_PHASE == 1) { __syncthreads(); gemm_bf16(F, XB, WIN, EVEN_LD, DM, BIG, EVEN_LD, false); } } SEAM(1);
    if (IN(2)) REPS(2) { phase_kmax(F); SNAKE_FOR(2048, k) { index_unit(F, k & 3, 8 * (511 - (k >> 2))); } } SEAM(2);
    if (IN(3)) {
        if (F.G == 256) {
            const int vcu3 = (F.bid % 8) * 32 + F.bid / 8, grp = vcu3 >> 4, j16 = vcu3 & 15, j8 = (j16 + 8) & 15;
#pragma unroll 1
            for (int rd = 0; rd < 4; ++rd) { const int bh = grp * 4 + rd; const int qb = rd == 0 ? 15 - j16 : (rd == 1 ? j16 : (rd == 2 ? 15 - j8 : j8));
                dsa_unit(F, bh >> 4, bh & 15, qb); }
            SNAKE_FOR(512, kk) { const int qb = 15 - (kk >> 5), bh = kk & 31; sb_unit(F, bh >> 3, bh & 7, qb); }
        } else {
        SNAKE_FOR(1024 + 512, k) {
            if (k < 1024) { const int qb = 15 - (k >> 6), bh = k & 63; dsa_unit(F, bh >> 4, bh & 15, qb); }
            else { const int kk = k - 1024; const int qb = 15 - (kk >> 5), bh = kk & 31; sb_unit(F, bh >> 3, bh & 7, qb); }
        }
        }
    } SEAM(3);
    if (IN(4)) { gemm_res(F, XB, WOUT, DM, F.in[0], F.out); } SEAM(4);
    if (IN(5)) { phase_ln(F, F.in[6], F.in[7], true); if (PROBE_PHASE == 99) { for (int q = 0; q < 20; ++q) xcd_barrier(bar); } } SEAM(5);
    if (IN(6)) { gemm_bf16(F, XB, W1, DFF, DM, BIG, DFF, true); } SEAM(6);
    if (IN(7)) { gemm_res_ln(F, BIG, W2, DFF, F.out, F.in[6], F.in[7]); } SEAM(7);
    if (IN(8)) { phase_ln(F, F.in[10], F.in[11], true); __syncthreads(); prep_weights(F, 1); } SEAM(8);
    if (IN(9)) { pg8::Gemm g{XB, WIN, MTOK, ODD_IN, DM}; pg8::StaticOrder S; S.init(MTOK, ODD_IN, F.G, F.bid); pg8::EpiBf16HeadMajor E{BIG};
        pg8::gemm_phase<pg8::EpiBf16HeadMajor, pg8::StaticOrder, PG8_ALIGN, PG8_SP2>((PG8_LAS unsigned char*)F.lds, g, S, E); } SEAM(9);
    const int vcu = (F.G % 8 == 0) ? (F.bid % 8) * (F.G / 8) + F.bid / 8 : F.bid;
#define DIL_RANGE(LO, HI) do { RowRegs<128> RK, RV; \
        if ((LO) + vcu < (HI)) { const DilItem it = dil_item((LO) + vcu); size_t gs; const bf16* kg = dil_kptr(F, it, it.nb == 0 ? 1 : 0, gs); \
            fetch_rows128<128>(RK, kg, gs, F.tid); fetch_rows128<128>(RV, kg + (size_t)MTOK * 2048, gs, F.tid); } \
        for (int k = (LO) + vcu; k < (HI); k += F.G) { \
            const DilItem it = dil_item(k); const bool hn = k + F.G < (HI); const DilItem nx = dil_item(hn ? k + F.G : k); \
            dil_unit(F, it, hn, nx, RK, RV); } } while (0)
    if (IN(10)) { DIL_RANGE(1024, 3072); } SEAM(10);
    if (IN(11)) { DIL_RANGE(0, 1024); } SEAM(11);
#undef DIL_RANGE
    if (IN(12)) { gemm_res_ln(F, XB, WOUT, DM, F.out, F.in[10], F.in[11]); } SEAM(12);
    if (IN(13)) { phase_ln(F, F.in[6] + DM, F.in[7] + DM, true); } SEAM(13);
    if (IN(14)) { gemm_bf16(F, XB, W1, DFF, DM, BIG, DFF, true); } SEAM(14);
    if (IN(15)) { gemm_res_ln(F, BIG, W2, DFF, F.out, F.in[6] + DM, F.in[7] + DM); } SEAM(15);
    if (IN(16)) { phase_ln(F, F.in[10] + DM, F.in[11] + DM, false); }
#undef IN
#undef SEAM
}

extern "C" void kernel_launch(void* const* d_in, const int* in_sizes, int n_in, void* d_out, int out_size, void* d_ws, size_t ws_size, hipStream_t stream) {
    static int grid = 0;
    if (grid == 0) {
        if (n_in != 12 || out_size != MTOK * DM || ws_size < WS_END) { fprintf(stderr, "kernel_launch: unexpected shapes (n_in %d out %d ws %zu)\n", n_in, out_size, ws_size); grid = -1; return; }
        int dev = 0, cus = 0, per_cu = 0;
        hipGetDevice(&dev); hipDeviceGetAttribute(&cus, hipDeviceAttributeMultiprocessorCount, dev);
        if (hipFuncSetAttribute((const void*)fwd, hipFuncAttributeMaxDynamicSharedMemorySize, LDS_BYTES) != hipSuccess) { fprintf(stderr, "kernel_launch: hipFuncSetAttribute failed\n"); grid = -1; return; }
        if (hipOccupancyMaxActiveBlocksPerMultiprocessor(&per_cu, (const void*)fwd, NTHR, LDS_BYTES) != hipSuccess || per_cu < 1) { fprintf(stderr, "kernel_launch: occupancy query says %d\n", per_cu); per_cu = 1; }
        (void)hipGetLastError();
        grid = cus * 1;
    }
    if (grid < 0) return;
    Args a{};
    for (int i = 0; i < 12; ++i) a.in[i] = (const float*)d_in[i];
    a.out = (float*)d_out; a.ws = (unsigned char*)d_ws;
#if MK_PER_PHASE
    for (int p = 0; p < N_PHASES; ++p) { a.ph_lo = p; a.ph_hi = p + 1; hipLaunchKernelGGL(fwd, dim3(grid), dim3(NTHR), LDS_BYTES, stream, a); }
#else
    a.ph_lo = 0; a.ph_hi = N_PHASES;
    if (hipMemsetAsync(d_ws, 0, 16384, stream) != hipSuccess) { fprintf(stderr, "kernel_launch: hipMemsetAsync of the barrier words failed\n"); return; }
    void* kargs[] = {&a};
    hipError_t e = hipLaunchCooperativeKernel((const void*)fwd, dim3(grid), dim3(NTHR), kargs, LDS_BYTES, stream);
    if (e != hipSuccess) fprintf(stderr, "cooperative launch failed: %s (grid %d)\n", hipGetErrorString(e), grid);
#endif
}
```

```cpp
#include <hip/hip_runtime.h>
#include <hip/hip_cooperative_groups.h>
#include <cstdio>
#include <cstdint>
namespace cg = cooperative_groups;
namespace pg8 {
#define PG8_LAS __attribute__((address_space(3)))
typedef unsigned short bf16_t;
typedef short bf16x8 __attribute__((ext_vector_type(8)));
typedef float f32x4 __attribute__((ext_vector_type(4)));
typedef unsigned u32x4 __attribute__((ext_vector_type(4)));
constexpr int BM = 256, BK = 64, HALF = 128, HTB = HALF * BK * 2  , STAGE_BYTES = 8 * HTB, NXCD = 8, WGM = 8;

__host__ __device__ __forceinline__ int lds_byte(int r, int c) { const int st = (r >> 4) * 2 + (c >> 5), rr = r & 15, cc = c & 31, ob = rr * 64 + cc * 2; return st * 1024 + (ob ^ (((ob >> 9) & 1) << 5)); }
__host__ __device__ __forceinline__ void stage_rc(int b, int& R, int& C) { const int st = b / 1024, sb = b % 1024, swz = sb ^ (((sb >> 9) & 1) << 5); R = (st >> 1) * 16 + swz / 64; C = (st & 1) * 32 + (swz % 64) / 2; }
__host__ __device__ __forceinline__ int perm32(int rho) { const int n = rho >> 4, i = rho & 15; return 8 * (i >> 2) + 4 * n + (i & 3); }

struct Unit { int pm, pn; };
struct Gemm { const bf16_t* A; const bf16_t* Bt; int M, N, K; };

struct StaticOrder {
    int nM, nN, nwg, G, c;
    __host__ __device__ void init(int M, int N, int G_, int c_) { nM = M / BM; nN = N / BM; nwg = nM * nN; G = G_; c = c_; }
    __host__ __device__ bool next(int i, Unit& u) const {
        const long L = (long)i * G + c; if (L >= nwg) return false;
        int wgid = (int)L; { const int q = nwg / NXCD, r = nwg % NXCD, xcd = wgid % NXCD, off = wgid / NXCD; wgid = (xcd < r ? xcd * (q + 1) : r * (q + 1) + (xcd - r) * q) + off; }
        const int nig = WGM * nN, gid = wgid / nig, fm = gid * WGM, gsz = (nM - fm) < WGM ? (nM - fm) : WGM;
        u.pm = fm + ((wgid % nig) % gsz); u.pn = (wgid % nig) / gsz; return true;
    }
    __device__ __forceinline__ void a_ready(const Unit&) const {}
    __device__ __forceinline__ void done(const Unit&) const {}
};

__device__ __forceinline__ unsigned cvt_pk_bf16(float lo, float hi) { unsigned r; asm volatile("v_cvt_pk_bf16_f32 %0, %1, %2" : "=v"(r) : "v"(lo), "v"(hi)); return r; }
template <int ACT> struct EpiBf16 {
    static constexpr bool PERM = true, AFTER_DRAIN = false;
    bf16_t* O; int ldc;
    __device__ __forceinline__ void operator()(const f32x4 (&acc)[2][2][4][2], const Unit& u, int wr, int wc, int fr, int fq) const {
        const int row0 = u.pm * BM + wr * 64 + fr; const int col0 = u.pn * BM + wc * 32 + 8 * fq;
#pragma unroll
        for (int ai = 0; ai < 2; ++ai)
#pragma unroll
            for (int m = 0; m < 4; ++m) { bf16_t* rowp = O + (size_t)(row0 + ai * HALF + m * 16) * ldc + col0;
#pragma unroll
                for (int bj = 0; bj < 2; ++bj) { f32x4 v0 = acc[ai][bj][m][0], v1 = acc[ai][bj][m][1];
                    if (ACT == 2) {
#pragma unroll
                        for (int q = 0; q < 4; ++q) { float a = v0[q] > 0.f ? v0[q] : 0.f; v0[q] = a * a; float b = v1[q] > 0.f ? v1[q] : 0.f; v1[q] = b * b; } }
                    u32x4 w; w.x = cvt_pk_bf16(v0[0], v0[1]); w.y = cvt_pk_bf16(v0[2], v0[3]); w.z = cvt_pk_bf16(v1[0], v1[1]); w.w = cvt_pk_bf16(v1[2], v1[3]);
                    *(u32x4*)(rowp + bj * HALF) = w; } }
    }
};
struct EpiResF32 {
    static constexpr bool PERM = true, AFTER_DRAIN = false;
    const float* res; float* out; int ldc; float alpha;
    __device__ __forceinline__ void operator()(const f32x4 (&acc)[2][2][4][2], const Unit& u, int wr, int wc, int fr, int fq) const {
        const int row0 = u.pm * BM + wr * 64 + fr; const int col0 = u.pn * BM + wc * 32 + 8 * fq;
#pragma unroll
        for (int ai = 0; ai < 2; ++ai)
#pragma unroll
            for (int m = 0; m < 4; ++m) { const size_t off = (size_t)(row0 + ai * HALF + m * 16) * ldc + col0;
#pragma unroll
                for (int bj = 0; bj < 2; ++bj) { const size_t p = off + bj * HALF;
                    const f32x4 r0 = *(const f32x4*)(res + p), r1 = *(const f32x4*)(res + p + 4);
                    *(f32x4*)(out + p) = r0 * alpha + acc[ai][bj][m][0]; *(f32x4*)(out + p + 4) = r1 * alpha + acc[ai][bj][m][1]; } }
    }
};

struct EpiResLnF32 {
    static constexpr bool PERM = true, AFTER_DRAIN = false;
    const float* res; float* out; int ldc; float alpha; const float* stats; const float* g; const float* b;
    __device__ __forceinline__ void operator()(const f32x4 (&acc)[2][2][4][2], const Unit& u, int wr, int wc, int fr, int fq) const {
        const int row0 = u.pm * BM + wr * 64 + fr; const int col0 = u.pn * BM + wc * 32 + 8 * fq;
#pragma unroll
        for (int bj = 0; bj < 2; ++bj) {
            const f32x4 g0 = *(const f32x4*)(g + col0 + bj * HALF), g1 = *(const f32x4*)(g + col0 + bj * HALF + 4);
            const f32x4 b0 = *(const f32x4*)(b + col0 + bj * HALF), b1 = *(const f32x4*)(b + col0 + bj * HALF + 4);
#pragma unroll
            for (int ai = 0; ai < 2; ++ai)
#pragma unroll
                for (int m = 0; m < 4; ++m) { const int row = row0 + ai * HALF + m * 16; const size_t p = (size_t)row * ldc + col0 + bj * HALF;
                    const float mean = stats[2 * row], rstd = stats[2 * row + 1];
                    const f32x4 r0 = *(const f32x4*)(res + p), r1 = *(const f32x4*)(res + p + 4);
                    const f32x4 n0 = (r0 - mean) * rstd * g0 + b0, n1 = (r1 - mean) * rstd * g1 + b1;
                    *(f32x4*)(out + p) = n0 * alpha + acc[ai][bj][m][0]; *(f32x4*)(out + p + 4) = n1 * alpha + acc[ai][bj][m][1]; }
        }
    }
};

struct EpiBf16HeadMajor {
    static constexpr bool PERM = true, AFTER_DRAIN = false;
    bf16_t* O;
    __device__ __forceinline__ void operator()(const f32x4 (&acc)[2][2][4][2], const Unit& u, int wr, int wc, int fr, int fq) const {
        const int row0 = u.pm * BM + wr * 64 + fr; const int col0 = u.pn * BM + wc * 32 + 8 * fq;
#pragma unroll
        for (int bj = 0; bj < 2; ++bj) { const int col = col0 + bj * HALF; const int which = col >> 11, h = (col >> 7) & 15, e = col & 127;
            bf16_t* base = O + (size_t)which * (16384u * 2048u) + (size_t)h * (4096u * 128u) + e;
#pragma unroll
            for (int ai = 0; ai < 2; ++ai)
#pragma unroll
                for (int m = 0; m < 4; ++m) { const int row = row0 + ai * HALF + m * 16; const int bb = row >> 12, s = row & 4095;
                    const f32x4 v0 = acc[ai][bj][m][0], v1 = acc[ai][bj][m][1];
                    u32x4 w; w.x = cvt_pk_bf16(v0[0], v0[1]); w.y = cvt_pk_bf16(v0[2], v0[3]); w.z = cvt_pk_bf16(v1[0], v1[1]); w.w = cvt_pk_bf16(v1[2], v1[3]);
                    *(u32x4*)(base + ((size_t)bb * 16 * 4096 + s) * 128) = w; } }
    }
};
template <class Epi, class Sched, bool ALIGN_EPI = false, bool SP2 = false>
__device__ __forceinline__ void gemm_phase(PG8_LAS unsigned char* lds, const Gemm g, const Sched& S, const Epi& E) {
    const int tid = threadIdx.x, wid = __builtin_amdgcn_readfirstlane(tid >> 6), lane = tid & 63, wr = wid >> 2, wc = wid & 3, fr = lane & 15, fq = lane >> 4;
    const int K = g.K, nt = K / BK;
    unsigned voffA[2], voffB[2];
#pragma unroll
    for (int i = 0; i < 2; ++i) { int R, C; stage_rc(tid * 16 + i * 8192, R, C); const int Rb = Epi::PERM ? ((R & ~31) + perm32(R & 31)) : R;
        voffA[i] = (unsigned)(R * K + C) * 2u; voffB[i] = (unsigned)(Rb * K + C) * 2u; }
    const size_t kstep = (size_t)(BK * 2);
    const size_t hstep = (size_t)HALF * K * 2;
    const size_t tstep = 2 * hstep;
    const unsigned ldsw = (unsigned)wid * 1024u;
    const int aoff = lds_byte(wr * 64 + fr, fq * 8), boff = lds_byte(wc * 32 + fr, fq * 8);
#define PG8_SA(b, h) (((b) * 2 + (h)) * HTB)
#define PG8_SB(b, h) ((4 + (b) * 2 + (h)) * HTB)
#define PG8_STAGE(bufoff, gbase, voff) do { _Pragma("unroll") for (int _i = 0; _i < 2; ++_i) \
        __builtin_amdgcn_global_load_lds((const unsigned*)((const char*)(gbase) + (voff)[_i]), (PG8_LAS unsigned*)(lds + (bufoff) + ldsw + _i * 8192), 16, 0, 0); } while (0)
#define PG8_LDA(dst, b, h) do { _Pragma("unroll") for (int m = 0; m < 4; ++m) _Pragma("unroll") for (int k = 0; k < 2; ++k) dst[m][k] = *(const PG8_LAS bf16x8*)(lds + PG8_SA(b, h) + aoff + m * 2048 + k * 1024); } while (0)
#define PG8_LDB(dst, b, h) do { _Pragma("unroll") for (int n = 0; n < 2; ++n) _Pragma("unroll") for (int k = 0; k < 2; ++k) dst[n][k] = *(const PG8_LAS bf16x8*)(lds + PG8_SB(b, h) + boff + n * 2048 + k * 1024); } while (0)
#define PG8_MMA(ai, bj, At, Bt) do { __builtin_amdgcn_s_setprio(1); _Pragma("unroll") for (int m = 0; m < 4; ++m) _Pragma("unroll") for (int n = 0; n < 2; ++n) _Pragma("unroll") for (int k = 0; k < 2; ++k) \
        acc[ai][bj][m][n] = __builtin_amdgcn_mfma_f32_16x16x32_bf16(Bt[n][k], At[m][k], acc[ai][bj][m][n], 0, 0, 0); __builtin_amdgcn_s_setprio(0); } while (0)
#define PG8_WAIT_V(n) asm volatile("s_waitcnt vmcnt(" #n ")" ::: "memory")
#define PG8_WAIT_L(n) asm volatile("s_waitcnt lgkmcnt(" #n ")" ::: "memory")
#define PG8_BAR __builtin_amdgcn_s_barrier()
#define PG8_SCHED __builtin_amdgcn_sched_barrier(0)
    Unit cur, nxt; int ui = 0;
    if (!S.next(0, cur)) return;
    f32x4 acc[2][2][4][2];
#pragma unroll
    for (int a = 0; a < 2; ++a)
#pragma unroll
        for (int b = 0; b < 2; ++b)
#pragma unroll
            for (int m = 0; m < 4; ++m)
#pragma unroll
                for (int n = 0; n < 2; ++n) acc[a][b][m][n] = (f32x4){0.f, 0.f, 0.f, 0.f};
    bf16x8 At[4][2], B0[2][2], B1[2][2];
    const char* cA = (const char*)g.A + (size_t)cur.pm * tstep; const char* cB = (const char*)g.Bt + (size_t)cur.pn * tstep;
    S.a_ready(cur);
    if constexpr (SP2) {
        PG8_STAGE(PG8_SB(0, 0), cB, voffB); PG8_STAGE(PG8_SB(0, 1), cB + hstep, voffB); PG8_STAGE(PG8_SA(0, 0), cA, voffA); PG8_STAGE(PG8_SA(0, 1), cA + hstep, voffA);
        if (wr == 1) PG8_BAR;
        PG8_WAIT_V(2); PG8_BAR;
        PG8_STAGE(PG8_SB(1, 0), cB + kstep, voffB); PG8_STAGE(PG8_SA(1, 0), cA + kstep, voffA); PG8_STAGE(PG8_SB(1, 1), cB + hstep + kstep, voffB);
        PG8_WAIT_V(6); PG8_BAR;
    } else {
        PG8_STAGE(PG8_SB(0, 0), cB, voffB); PG8_STAGE(PG8_SA(0, 0), cA, voffA); PG8_STAGE(PG8_SB(0, 1), cB + hstep, voffB); PG8_STAGE(PG8_SA(0, 1), cA + hstep, voffA);
        if (wr == 1) PG8_BAR;
        PG8_WAIT_V(4); PG8_BAR;
        PG8_STAGE(PG8_SB(1, 0), cB + kstep, voffB); PG8_STAGE(PG8_SA(1, 0), cA + kstep, voffA); PG8_STAGE(PG8_SB(1, 1), cB + hstep + kstep, voffB);
        PG8_WAIT_V(6); PG8_BAR;
    }
    for (;;) {
        const bool has_next = S.next(ui + 1, nxt);
        const char* nA = has_next ? (const char*)g.A + (size_t)nxt.pm * tstep : cA; const char* nB = has_next ? (const char*)g.Bt + (size_t)nxt.pn * tstep : cB;
        for (int t = 0; t < nt; t += 2) {
            const bool last = (t == nt - 2);
            const char* a1 = cA + (size_t)(t + 1) * kstep;
            const char* a2 = last ? nA : cA + (size_t)(t + 2) * kstep; const char* b2 = last ? nB : cB + (size_t)(t + 2) * kstep;
            const char* a3 = a2 + kstep; const char* b3 = b2 + kstep;
            if (last && has_next) S.a_ready(nxt);
            if constexpr (SP2) {
            PG8_LDB(B0, 0, 0); PG8_LDB(B1, 0, 1); PG8_SCHED; PG8_LDA(At, 0, 0); PG8_STAGE(PG8_SA(1, 1), a1 + hstep, voffA);
            PG8_WAIT_V(8); PG8_WAIT_L(0); PG8_BAR; PG8_MMA(0, 0, At, B0); PG8_MMA(0, 1, At, B1); PG8_BAR; PG8_SCHED;
            PG8_LDA(At, 0, 1); PG8_STAGE(PG8_SB(0, 0), b2, voffB); PG8_STAGE(PG8_SB(0, 1), b2 + hstep, voffB); PG8_STAGE(PG8_SA(0, 0), a2, voffA);
            PG8_WAIT_V(8); PG8_WAIT_L(0); PG8_BAR; PG8_MMA(1, 0, At, B0); PG8_MMA(1, 1, At, B1); PG8_BAR; PG8_SCHED;
            PG8_LDB(B0, 1, 0); PG8_LDB(B1, 1, 1); PG8_SCHED; PG8_LDA(At, 1, 0); PG8_STAGE(PG8_SA(0, 1), a2 + hstep, voffA);
            PG8_WAIT_V(8); PG8_WAIT_L(0); PG8_BAR; PG8_MMA(0, 0, At, B0); PG8_MMA(0, 1, At, B1); PG8_BAR; PG8_SCHED;
            PG8_LDA(At, 1, 1); PG8_STAGE(PG8_SB(1, 0), b3, voffB); PG8_STAGE(PG8_SB(1, 1), b3 + hstep, voffB); PG8_STAGE(PG8_SA(1, 0), a3, voffA);
            PG8_WAIT_V(8); PG8_WAIT_L(0); PG8_BAR; PG8_MMA(1, 0, At, B0); PG8_MMA(1, 1, At, B1); PG8_BAR; PG8_SCHED;
            } else {
            PG8_LDB(B0, 0, 0); PG8_SCHED; PG8_LDA(At, 0, 0); PG8_STAGE(PG8_SA(1, 1), a1 + hstep, voffA);
            PG8_WAIT_L(8); PG8_BAR; PG8_WAIT_L(0); PG8_MMA(0, 0, At, B0); PG8_BAR; PG8_SCHED;
            PG8_LDB(B1, 0, 1); PG8_STAGE(PG8_SB(0, 0), b2, voffB);
            PG8_BAR; PG8_WAIT_L(0); PG8_MMA(0, 1, At, B1); PG8_BAR;
            PG8_LDA(At, 0, 1); PG8_STAGE(PG8_SA(0, 0), a2, voffA);
            PG8_BAR; PG8_WAIT_L(0); PG8_MMA(1, 0, At, B0); PG8_BAR; PG8_SCHED;
            PG8_STAGE(PG8_SB(0, 1), b2 + hstep, voffB);
            PG8_WAIT_V(6); PG8_BAR; PG8_MMA(1, 1, At, B1); PG8_BAR;
            PG8_LDB(B0, 1, 0); PG8_SCHED; PG8_LDA(At, 1, 0); PG8_STAGE(PG8_SA(0, 1), a2 + hstep, voffA);
            PG8_WAIT_L(8); PG8_BAR; PG8_WAIT_L(0); PG8_MMA(0, 0, At, B0); PG8_BAR; PG8_SCHED;
            PG8_LDB(B1, 1, 1); PG8_STAGE(PG8_SB(1, 0), b3, voffB);
            PG8_BAR; PG8_WAIT_L(0); PG8_MMA(0, 1, At, B1); PG8_BAR;
            PG8_LDA(At, 1, 1); PG8_STAGE(PG8_SA(1, 0), a3, voffA);
            PG8_BAR; PG8_WAIT_L(0); PG8_MMA(1, 0, At, B0); PG8_BAR; PG8_SCHED;
            PG8_STAGE(PG8_SB(1, 1), b3 + hstep, voffB);
            PG8_WAIT_V(6); PG8_BAR; PG8_MMA(1, 1, At, B1); PG8_BAR;
            }
        }
        if constexpr (ALIGN_EPI) { if (wr == 0) PG8_BAR; }
        if constexpr (!Epi::AFTER_DRAIN) { E(acc, cur, wr, wc, fr, fq); S.done(cur); }
        if (!has_next) break;
#pragma unroll
        for (int a = 0; a < 2; ++a)
#pragma unroll
            for (int b = 0; b < 2; ++b)
#pragma unroll
                for (int m = 0; m < 4; ++m)
#pragma unroll
                    for (int n = 0; n < 2; ++n) acc[a][b][m][n] = (f32x4){0.f, 0.f, 0.f, 0.f};
        cur = nxt; cA = nA; cB = nB; ++ui;
        if constexpr (ALIGN_EPI) { if (wr == 1) PG8_BAR; }
    }
    PG8_WAIT_V(0);
    if constexpr (!ALIGN_EPI) { if (wr == 0) PG8_BAR; }
    PG8_BAR;
    if constexpr (Epi::AFTER_DRAIN) { E.fused(acc, cur, wr, wc, fr, fq, lds, wid, lane); S.done(cur); }
#undef PG8_SA
#undef PG8_SB
#undef PG8_STAGE
#undef PG8_LDA
#undef PG8_LDB
#undef PG8_MMA
#undef PG8_WAIT_V
#undef PG8_WAIT_L
#undef PG8_BAR
#undef PG8_SCHED
}
}

constexpr int BATCH = 4, SEQ = 4096, DM = 2048, MTOK = BATCH * SEQ;
constexpr int EVEN_IN = 6728, EVEN_LD = 6912, ODD_IN = 6144, DFF = 8192;
constexpr int NWAVES = 8, NTHR = NWAVES * 64;
constexpr float DN_ALPHA = 1.4142135623730951f, LN_EPS = 1e-5f, LOG2E = 1.4426950408889634f;
constexpr float C_D128 = 0.08838834764831845f * LOG2E, C_D64 = 0.125f * LOG2E;
constexpr int C_QA = 0, C_KA = 1024, C_VA = 2048, C_QB = 3072, C_KB = 4096, C_VB = 5120, C_QI = 6144, C_KI = 6656, C_WI = 6720;
#ifndef MK_PER_PHASE
#define MK_PER_PHASE 0
#endif
constexpr int N_PHASES = 17;
#ifndef PG8_ALIGN
#define PG8_ALIGN true
#endif
#ifndef PG8_SP2
#define PG8_SP2 true
#endif
#ifndef PROBE_PHASE
#define PROBE_PHASE -1
#endif
#define REPS(k) for (int _rep = 0; _rep < ((PROBE_PHASE) == (k) ? 2 : 1); ++_rep)

constexpr size_t MiB = 1u << 20;
constexpr size_t WS_BIASD = 1 * MiB;
constexpr size_t WS_BIASDIL = 1 * MiB + 512 * 1024;
constexpr size_t WS_MASK = 2 * MiB;
constexpr size_t WS_STAT = 10 * MiB;
constexpr size_t WS_KMAX = 1 * MiB + 768 * 1024;
constexpr size_t WS_LNST = 17 * MiB;
constexpr size_t WS_WIN = 20 * MiB, WS_WOUT = 47 * MiB, WS_W1 = 55 * MiB, WS_W2 = 87 * MiB;
constexpr size_t WS_XB = 120 * MiB;
constexpr size_t WS_BIG = 184 * MiB;
constexpr size_t WS_OG = WS_BIG + 192 * MiB;
constexpr size_t WS_END = 504 * MiB;

constexpr int LDS_BYTES = 147456;

#define LAS __attribute__((address_space(3)))
typedef unsigned short bf16;
typedef short bf16x8 __attribute__((ext_vector_type(8)));
typedef short s16x4 __attribute__((ext_vector_type(4)));
typedef float f32x4 __attribute__((ext_vector_type(4)));
typedef float f32x16 __attribute__((ext_vector_type(16)));
typedef unsigned u32x4 __attribute__((ext_vector_type(4)));
typedef unsigned u32x2 __attribute__((ext_vector_type(2)));
typedef float f32x2_t __attribute__((ext_vector_type(2)));
typedef __bf16 bf16x2_t __attribute__((ext_vector_type(2)));
typedef short v4i16_t __attribute__((ext_vector_type(4)));
#define DI __device__ __forceinline__
#define MFMA32(a, b, c) __builtin_amdgcn_mfma_f32_32x32x16_bf16((a), (b), (c), 0, 0, 0)

DI unsigned cvtpk(float lo, float hi) { f32x2_t v = {lo, hi}; bf16x2_t b = __builtin_convertvector(v, bf16x2_t); return __builtin_bit_cast(unsigned, b); }
DI float bf2f(unsigned short h) { return __uint_as_float(((unsigned)h) << 16); }
DI int crow(int i, int h) { return (i & 3) + 8 * (i >> 2) + 4 * h; }
DI float ex2(float x) { return __builtin_amdgcn_exp2f(x); }
DI float lg2(float x) { return __builtin_amdgcn_logf(x); }
DI float swap_max(float m) { auto rr = __builtin_amdgcn_permlane32_swap(__float_as_uint(m), __float_as_uint(m), false, false); return fmaxf(__uint_as_float(rr[0]), __uint_as_float(rr[1])); }
DI float swap_sum(float m) { auto rr = __builtin_amdgcn_permlane32_swap(__float_as_uint(m), __float_as_uint(m), false, false); return __uint_as_float(rr[0]) + __uint_as_float(rr[1]); }
DI float swap_other(float m, int hf) { auto rr = __builtin_amdgcn_permlane32_swap(__float_as_uint(m), __float_as_uint(m), false, false); return hf ? __uint_as_float(rr[0]) : __uint_as_float(rr[1]); }
DI bf16x8 pack8(const f32x16& x, int s) {
    u32x4 p; p.x = cvtpk(x[8 * s], x[8 * s + 1]); p.y = cvtpk(x[8 * s + 2], x[8 * s + 3]); p.z = cvtpk(x[8 * s + 4], x[8 * s + 5]); p.w = cvtpk(x[8 * s + 6], x[8 * s + 7]);
    return __builtin_bit_cast(bf16x8, p);
}
DI s16x4 vtr(LAS const char* p) { return __builtin_bit_cast(s16x4, __builtin_amdgcn_ds_read_tr16_b64_v4i16((LAS v4i16_t*)p)); }
DI int rel_bucket(int d) {
    if (d < 16) return d;
    const float df = (float)d;
    int large = 16 + (int)(logf(df / 16.f) / 4.852030263919617f * 16.f);
    return large < 31 ? large : 31;
}

struct Frame {
    LAS unsigned char* lds;
    int tid, lane, wave, G, bid;
    const float* in[12]; float* out; unsigned char* ws;
};

DI void transpose_item(const float* W, int K, int N, bf16* WT, LAS float* scr, int item, int nblk, int lane) {
    const int kb = item / nblk, nb = item % nblk, k0 = 64 * kb, n0 = 32 * nb;
    const int nn = n0 + (lane & 31);
    float wreg[32];
#pragma unroll
    for (int i = 0; i < 32; ++i) { const int kk = 2 * i + (lane >> 5); wreg[i] = (nn < N) ? __builtin_nontemporal_load(W + (size_t)(k0 + kk) * N + nn) : 0.f; }
#pragma unroll
    for (int i = 0; i < 32; ++i) { const int kk = 2 * i + (lane >> 5); scr[kk * 33 + (lane & 31)] = wreg[i]; }
    asm volatile("s_waitcnt lgkmcnt(0)" ::: "memory");
    const int c = lane & 7;
#pragma unroll
    for (int j = 0; j < 4; ++j) { const int n = (lane >> 3) + 8 * j; const LAS float* s = scr + (8 * c) * 33 + n;
        u32x4 o; o.x = cvtpk(s[0 * 33], s[1 * 33]); o.y = cvtpk(s[2 * 33], s[3 * 33]); o.z = cvtpk(s[4 * 33], s[5 * 33]); o.w = cvtpk(s[6 * 33], s[7 * 33]);
        *(u32x4*)(WT + (size_t)(n0 + n) * K + k0 + 8 * c) = o; }
    asm volatile("s_waitcnt lgkmcnt(0)" ::: "memory");
}

DI void prep_weights(Frame& F, int layer) {
    LAS float* scr = (LAS float*)(F.lds + F.wave * 16384);
    const int gw = F.bid * NWAVES + F.wave, NGW = F.G * NWAVES;
    const float* Win = layer == 0 ? F.in[1] : F.in[3];
    const float* Wout = layer == 0 ? F.in[2] : F.in[4];
    const float* W1 = F.in[8] + (size_t)layer * DM * DFF;
    const float* W2 = F.in[9] + (size_t)layer * DFF * DM;
    const int Nin = layer == 0 ? EVEN_IN : ODD_IN, Npad = layer == 0 ? EVEN_LD : ODD_IN;
    const int nb_in = Npad / 32;
    const int I_IN = (DM / 64) * nb_in, I_OUT = (DM / 64) * (DM / 32), I_1 = (DM / 64) * (DFF / 32), I_2 = (DFF / 64) * (DM / 32);
    const int NIT = I_IN + I_OUT + I_1 + I_2;
    for (int it = gw; it < NIT; it += NGW) {
        int r = it;
        if (r < I_IN) { transpose_item(Win, DM, Nin, (bf16*)(F.ws + WS_WIN), scr, r, nb_in, F.lane); continue; } r -= I_IN;
        if (r < I_OUT) { transpose_item(Wout, DM, DM, (bf16*)(F.ws + WS_WOUT), scr, r, DM / 32, F.lane); continue; } r -= I_OUT;
        if (r < I_1) { transpose_item(W1, DM, DFF, (bf16*)(F.ws + WS_W1), scr, r, DFF / 32, F.lane); continue; } r -= I_1;
        transpose_item(W2, DFF, DM, (bf16*)(F.ws + WS_W2), scr, r, DM / 32, F.lane);
    }
}

DI void prep_misc(Frame& F) {
    const size_t gt = (size_t)F.bid * NTHR + F.tid, NT = (size_t)F.G * NTHR;
    const float* x = F.in[0]; bf16* xb = (bf16*)(F.ws + WS_XB);
#pragma unroll 4
    for (size_t i = gt; i < (size_t)MTOK * DM / 8; i += NT) {
        const f32x4 a = __builtin_nontemporal_load((const f32x4*)(x + i * 8)), b = __builtin_nontemporal_load((const f32x4*)(x + i * 8 + 4));
        u32x4 o; o.x = cvtpk(a[0], a[1]); o.y = cvtpk(a[2], a[3]); o.z = cvtpk(b[0], b[1]); o.w = cvtpk(b[2], b[3]);
        *(u32x4*)(xb + i * 8) = o;
    }
    const float* rb = F.in[5];
    float* bd = (float*)(F.ws + WS_BIASD);
    for (size_t i = gt; i < 16 * 4096; i += NT) { const int h = (int)(i >> 12), d = (int)(i & 4095); bd[i] = rb[rel_bucket(d) * 16 + h] * LOG2E; }
    if (gt < 64) ((unsigned*)(F.ws + WS_KMAX))[gt] = 0u;
    if (gt < 16) { float bm = -1e30f; for (int k = 0; k < 32; ++k) bm = fmaxf(bm, rb[k * 16 + (int)gt]); ((float*)(F.ws + WS_KMAX + 256))[gt] = bm * LOG2E; }
    float* bdl = (float*)(F.ws + WS_BIASDIL);
    for (size_t i = gt; i < 3 * 16 * 160; i += NT) { const int g = (int)(i / (16 * 160)), rem = (int)(i % (16 * 160)), h = rem / 160, j = rem % 160;
        const int dil = g == 0 ? 1 : (g == 1 ? 4 : 16); const int dist = (j <= 128 ? j : 128) * dil;
        bdl[i] = rb[rel_bucket(dist) * 16 + h] * LOG2E; }
}

DI float wave_sum(float v) {
#pragma unroll
    for (int o = 1; o < 64; o <<= 1) v += __shfl_xor(v, o);
    return v;
}
DI void phase_ln(Frame& F, const float* g, const float* b, bool lazy) {
    const int gw = F.bid * NWAVES + F.wave, NGW = F.G * NWAVES;
    bf16* xb = (bf16*)(F.ws + WS_XB); float* lnst = (float*)(F.ws + WS_LNST);
    f32x4 gv[8], bv[8];
#pragma unroll
    for (int j = 0; j < 8; ++j) { gv[j] = *(const f32x4*)(g + 256 * j + 4 * F.lane); bv[j] = *(const f32x4*)(b + 256 * j + 4 * F.lane); }
    f32x4 vn[8];
    if (gw < MTOK) {
#pragma unroll
        for (int j = 0; j < 8; ++j) vn[j] = *(const f32x4*)(F.out + (size_t)gw * DM + 4 * F.lane + 256 * j); }
    for (int row = gw; row < MTOK; row += NGW) {
        float* xr = F.out + (size_t)row * DM + 4 * F.lane;
        f32x4 v[8]; float s = 0.f;
#pragma unroll
        for (int j = 0; j < 8; ++j) { v[j] = vn[j]; s += (v[j][0] + v[j][1]) + (v[j][2] + v[j][3]); }
        if (row + NGW < MTOK) {
#pragma unroll
            for (int j = 0; j < 8; ++j) vn[j] = *(const f32x4*)(xr + (size_t)NGW * DM + 256 * j); }
        const float mean = wave_sum(s) * (1.f / DM); float s2 = 0.f;
#pragma unroll
        for (int j = 0; j < 8; ++j) { v[j] = v[j] - mean; s2 += (v[j][0] * v[j][0] + v[j][1] * v[j][1]) + (v[j][2] * v[j][2] + v[j][3] * v[j][3]); }
        const float rstd = 1.f / sqrtf(wave_sum(s2) * (1.f / DM) + LN_EPS);
        if (lazy && F.lane == 0) { lnst[2 * row] = mean; lnst[2 * row + 1] = rstd; }
#pragma unroll
        for (int j = 0; j < 8; ++j) { const f32x4 y = v[j] * rstd * gv[j] + bv[j];
            if (lazy) { u32x2 o; o.x = cvtpk(y[0], y[1]); o.y = cvtpk(y[2], y[3]); *(u32x2*)(xb + (size_t)row * DM + 256 * j + 4 * F.lane) = o; }
            else __builtin_nontemporal_store(y, (f32x4*)(xr + 256 * j)); }
    }
}

template <int D> struct RowRegs { u32x4 v[128 * (D / 8) / NTHR]; };
template <int D>
DI void fetch_rows128(RowRegs<D>& R, const bf16* g0, size_t gstride, int tid) {
    constexpr int CPR = D / 8, NCH = 128 * CPR / NTHR;
#pragma unroll
    for (int k = 0; k < NCH; ++k) { const int c = tid + k * NTHR, r = c / CPR, q = c % CPR; R.v[k] = *(const u32x4*)(g0 + (size_t)r * gstride + q * 8); }
}
template <int D, int STR>
DI void put_rows128(LAS unsigned char* dst, const RowRegs<D>& R, int tid) {
    constexpr int CPR = D / 8, NCH = 128 * CPR / NTHR;
#pragma unroll
    for (int k = 0; k < NCH; ++k) { const int c = tid + k * NTHR, r = c / CPR, q = c % CPR; *(LAS u32x4*)(dst + r * STR + q * 16) = R.v[k]; }
}
template <int D, int STR>
DI f32x16 st_tile(LAS const unsigned char* Ks, int krow0, const bf16x8* qf, int tl, int hf) {
    f32x16 x;
#pragma unroll
    for (int i = 0; i < 16; ++i) x[i] = 0.f;
    LAS const unsigned char* kp = Ks + (krow0 + tl) * STR + hf * 16;
#pragma unroll
    for (int st = 0; st < D / 16; ++st) { const bf16x8 kf = *(LAS const bf16x8*)(kp + st * 32); x = MFMA32(kf, qf[st], x); }
    return x;
}
template <int D, int STR>
DI void pv_tile(f32x16* acc, LAS const unsigned char* Vs, int vrow0, bf16x8 p0, bf16x8 p1, int lane) {
    const int hf = lane >> 5, q = (lane & 15) >> 2, p = lane & 3, blk = (lane >> 4) & 1;
    LAS const char* vb = (LAS const char*)Vs + (vrow0 + 4 * hf + q) * STR + blk * 32 + p * 8;
#pragma unroll
    for (int eb = 0; eb < D / 32; ++eb) {
        const s16x4 l0 = vtr(vb + eb * 64), h0 = vtr(vb + 8 * STR + eb * 64);
        const s16x4 l1 = vtr(vb + 16 * STR + eb * 64), h1 = vtr(vb + 24 * STR + eb * 64);
        const bf16x8 v0 = __builtin_shufflevector(l0, h0, 0, 1, 2, 3, 4, 5, 6, 7), v1 = __builtin_shufflevector(l1, h1, 0, 1, 2, 3, 4, 5, 6, 7);
        acc[eb] = MFMA32(v0, p0, acc[eb]); acc[eb] = MFMA32(v1, p1, acc[eb]);
    }
}
template <int D>
DI void store_ot(const f32x16* acc, float inv, bf16* orow, int hf) {
#pragma unroll
    for (int eb = 0; eb < D / 32; ++eb)
#pragma unroll
        for (int k = 0; k < 4; ++k) { u32x2 o; o.x = cvtpk(acc[eb][4 * k] * inv, acc[eb][4 * k + 1] * inv); o.y = cvtpk(acc[eb][4 * k + 2] * inv, acc[eb][4 * k + 3] * inv);
            *(u32x2*)(orow + 32 * eb + 8 * k + 4 * hf) = o; }
}

template <int D, int STR>
DI void load_q_frags(Frame& F, bf16x8* qf, const bf16* g0, size_t gstride, LAS unsigned char* buf) {
    constexpr int CPR = D / 8, NCH = 256 * CPR / NTHR;
    __syncthreads();
    int tid_ = F.tid; asm volatile("" : "+v"(tid_));
#pragma unroll
    for (int hb = 0; hb < NCH; hb += 4) { u32x4 v[4];
#pragma unroll
      for (int k = 0; k < 4; ++k) { const int c = tid_ + (hb + k) * NTHR, r = c / CPR, q = c % CPR; v[k] = *(const u32x4*)(g0 + (size_t)r * gstride + q * 8); }
#pragma unroll
      for (int k = 0; k < 4; ++k) { const int c = tid_ + (hb + k) * NTHR, r = c / CPR, q = c % CPR; *(LAS u32x4*)(buf + r * STR + q * 16) = v[k]; } }
    __syncthreads();
    int lane_ = F.lane; asm volatile("" : "+v"(lane_));
    LAS const unsigned char* qp = buf + (32 * F.wave + (lane_ & 31)) * STR + 16 * (lane_ >> 5);
#pragma unroll
    for (int st = 0; st < D / 16; ++st) qf[st] = *(LAS const bf16x8*)(qp + 32 * st);
}
template <int D, int STR>
DI void store_o_rows(Frame& F, const f32x16* acc, float inv, bf16* o0, size_t gstride, LAS unsigned char* buf) {
    constexpr int CPR = D / 8, NCH = 32 * CPR / 64;
    int lane_ = F.lane; asm volatile("" : "+v"(lane_));
    const int tl = lane_ & 31, hf = lane_ >> 5;
    __syncthreads();
    LAS unsigned char* my = buf + F.wave * 32 * STR;
#pragma unroll
    for (int eb = 0; eb < D / 32; ++eb)
#pragma unroll
        for (int k = 0; k < 4; ++k) { u32x2 o; o.x = cvtpk(acc[eb][4 * k] * inv, acc[eb][4 * k + 1] * inv); o.y = cvtpk(acc[eb][4 * k + 2] * inv, acc[eb][4 * k + 3] * inv);
            *(LAS u32x2*)(my + tl * STR + (32 * eb + 8 * k + 4 * hf) * 2) = o; }
    asm volatile("s_waitcnt lgkmcnt(0)" ::: "memory");
#pragma unroll
    for (int i = 0; i < NCH; ++i) { const int c = lane_ + 64 * i, r = c / CPR, q = c % CPR;
        const u32x4 v = *(LAS const u32x4*)(my + r * STR + q * 16);
        *(u32x4*)(o0 + (size_t)(32 * F.wave + r) * gstride + q * 8) = v; }
}

constexpr int KSTR128 = 272, VSTR128 = 288, KSTR64 = 144, VSTR64 = 144;
constexpr int ATT_K_OFF = 0, ATT_V_OFF = 36864, ATT_TB_OFF = 73728, ATT_FLAG_OFF = 73728 + 16384;

DI void sb_unit(Frame& F, int b, int h, int qb) {
    const bf16* H0 = (const bf16*)(F.ws + WS_BIG); bf16* O = (bf16*)(F.ws + WS_XB);
    LAS unsigned char* Ks = F.lds + ATT_K_OFF; LAS unsigned char* Vs = F.lds + ATT_V_OFF;
    volatile LAS int* flags = (volatile LAS int*)(F.lds + ATT_FLAG_OFF);
    const int lane = F.lane, w = F.wave, tl = lane & 31, hf = lane >> 5;
    const int t0 = 256 * qb, tw = t0 + 32 * w, t = tw + tl;
    __syncthreads();
    if (F.tid < 8) flags[F.tid] = 0;
    bf16x8 qf[8];
    load_q_frags<128, KSTR128>(F, qf, H0 + (size_t)(b * SEQ + t0) * EVEN_LD + C_QA + h * 128, EVEN_LD, Ks);
    f32x16 acc[4];
#pragma unroll
    for (int e = 0; e < 4; ++e)
#pragma unroll
        for (int i = 0; i < 16; ++i) acc[e][i] = 0.f;
    float carry = 0.f; bool wdone = false;
    RowRegs<128> RK, RV;
    const int jtop = (t0 + 255) >> 7;
    { const bf16* kg = H0 + (size_t)(b * SEQ + 128 * jtop) * EVEN_LD + C_KA + h * 128;
      fetch_rows128<128>(RK, kg, EVEN_LD, F.tid); fetch_rows128<128>(RV, kg + (C_VA - C_KA), EVEN_LD, F.tid); }
    for (int j = jtop; j >= 0; --j) {
        __syncthreads();
        { int alld = 1;
#pragma unroll
          for (int k = 0; k < 8; ++k) alld &= flags[k];
          if (alld) break; }
        put_rows128<128, KSTR128>(Ks, RK, F.tid); put_rows128<128, VSTR128>(Vs, RV, F.tid);
        __syncthreads();
        if (j > 0) { const bf16* kg = H0 + (size_t)(b * SEQ + 128 * (j - 1)) * EVEN_LD + C_KA + h * 128;
            fetch_rows128<128>(RK, kg, EVEN_LD, F.tid); fetch_rows128<128>(RV, kg + (C_VA - C_KA), EVEN_LD, F.tid); }
        if (!wdone) {
#pragma unroll 1
            for (int kt = 3; kt >= 0; --kt) {
                const int s0 = 128 * j + 32 * kt;
                if (s0 > tw) continue;
                f32x16 x = st_tile<128, KSTR128>(Ks, 32 * kt, qf, tl, hf);
                float lk[16];
#pragma unroll
                for (int i = 0; i < 16; ++i) {
                    const int s = s0 + crow(i, hf);
                    const float z2 = x[i] * C_D128;
                    const float e = ex2(-fabsf(z2));
                    const float L2 = fmaxf(-z2, 0.f) + lg2(1.f + e);
                    const bool valid = s < t;
                    lk[i] = valid ? (-z2 - L2) : 0.f;
                    x[i] = valid ? -L2 : -1e30f;
                }
                float gs[4], pg[4];
#pragma unroll
                for (int k = 0; k < 4; ++k) { gs[k] = (lk[4 * k] + lk[4 * k + 1]) + (lk[4 * k + 2] + lk[4 * k + 3]); pg[k] = swap_other(gs[k], hf); }
                float above[4];
                { float run = 0.f;
#pragma unroll
                  for (int k = 3; k >= 0; --k) { above[k] = run + (hf == 0 ? pg[k] : 0.f); run += gs[k] + pg[k]; }
                  const float base = carry; carry += run;
#pragma unroll
                  for (int k = 0; k < 4; ++k) {
                      const float a3 = base + above[k];
                      const float a2 = a3 + lk[4 * k + 3], a1 = a2 + lk[4 * k + 2], a0 = a1 + lk[4 * k + 1];
                      x[4 * k + 3] = ex2(x[4 * k + 3] + a3); x[4 * k + 2] = ex2(x[4 * k + 2] + a2);
                      x[4 * k + 1] = ex2(x[4 * k + 1] + a1); x[4 * k] = ex2(x[4 * k] + a0);
                  } }
                const bf16x8 p0 = pack8(x, 0), p1 = pack8(x, 1);
                pv_tile<128, VSTR128>(acc, Vs, 32 * kt, p0, p1, lane);
            }
            wdone = __all(carry < -200.f);
            if (wdone && lane == 0) flags[w] = 1;
        }
    }
    store_o_rows<128, KSTR128>(F, acc, 1.f, O + (size_t)(b * SEQ + t0) * DM + h * 128, DM, Ks);
}

DI float bfi_f(unsigned m, float a, float b) { return __uint_as_float((__float_as_uint(a) & m) | (__float_as_uint(b) & ~m)); }
DI void dsa_unit(Frame& F, int b, int h, int qb) {
    const bf16* H0 = (const bf16*)(F.ws + WS_BIG); bf16* O = (bf16*)(F.ws + WS_XB);
    const unsigned* mask = (const unsigned*)(F.ws + WS_MASK);
    LAS unsigned char* Ks = F.lds + ATT_K_OFF; LAS unsigned char* Vs = F.lds + ATT_V_OFF;
    LAS float* tb = (LAS float*)(F.lds + ATT_TB_OFF);
    const int lane = F.lane, w = F.wave, tl = lane & 31, hf = lane >> 5;
    const int t0 = 256 * qb, tw = t0 + 32 * w, t = tw + tl;
    __syncthreads();
    { const float* bd = (const float*)(F.ws + WS_BIASD) + h * 4096;
      for (int i = F.tid; i < 4096; i += NTHR) tb[4095 - i] = bd[i]; }
    bf16x8 qf[4];
    load_q_frags<64, KSTR64>(F, qf, H0 + (size_t)(b * SEQ + t0) * EVEN_LD + C_QB + h * 64, EVEN_LD, Ks);
    f32x16 acc[2];
#pragma unroll
    for (int e = 0; e < 2; ++e)
#pragma unroll
        for (int i = 0; i < 16; ++i) acc[e][i] = 0.f;
    float S;
    { float qn = 0.f;
#pragma unroll
      for (int st = 0; st < 4; ++st)
#pragma unroll
          for (int q = 0; q < 8; ++q) { const float v = __uint_as_float(((unsigned)(unsigned short)qf[st][q]) << 16); qn += v * v; }
      qn = swap_sum(qn);
      const float k2 = __uint_as_float(((const unsigned*)(F.ws + WS_KMAX))[b * 16 + h]);
      const float U = sqrtf(qn * k2) * C_D64 * 1.001f + ((const float*)(F.ws + WS_KMAX + 256))[h] + 0.01f;
      S = fmaxf(U - 100.f, 0.f); }
    const bool noshift = __all(S == 0.f);
    float l = 0.f;
    const unsigned* mrow = mask + (size_t)(b * SEQ + t) * 128;
    const int jmax = (t0 + 255) >> 7;
    RowRegs<64> RK, RV;
    { const bf16* kg = H0 + (size_t)(b * SEQ) * EVEN_LD + C_KB + h * 64;
      fetch_rows128<64>(RK, kg, EVEN_LD, F.tid); fetch_rows128<64>(RV, kg + (C_VB - C_KB), EVEN_LD, F.tid); }
    u32x4 mwn = *(const u32x4*)(mrow);
    for (int j = 0; j <= jmax; ++j) {
        __syncthreads();
        put_rows128<64, KSTR64>(Ks, RK, F.tid); put_rows128<64, VSTR64>(Vs, RV, F.tid);
        const u32x4 mw4 = mwn;
        __syncthreads();
        if (j < jmax) { const bf16* kg = H0 + (size_t)(b * SEQ + 128 * (j + 1)) * EVEN_LD + C_KB + h * 64;
            fetch_rows128<64>(RK, kg, EVEN_LD, F.tid); fetch_rows128<64>(RV, kg + (C_VB - C_KB), EVEN_LD, F.tid);
            mwn = *(const u32x4*)(mrow + 4 * (j + 1)); }
#pragma unroll
        for (int kt = 0; kt < 4; ++kt) {
            const int s0 = 128 * j + 32 * kt;
            if (s0 > tw + 31) continue;
            const unsigned mws = mw4[kt] >> (4 * hf);
            f32x16 x = st_tile<64, KSTR64>(Ks, 32 * kt, qf, tl, hf);
            const LAS float* tp = tb + (4095 - (t - s0 - 4 * hf));
            if (noshift) {
#pragma unroll
                for (int i = 0; i < 16; ++i) {
                    const int ci = (i & 3) + 8 * (i >> 2);
                    const unsigned mm = (unsigned)__builtin_amdgcn_sbfe((int)mws, ci, 1);
                    x[i] = ex2(bfi_f(mm, x[i] * C_D64 + tp[ci], -INFINITY));
                    l += x[i];
                }
            } else {
#pragma unroll
                for (int i = 0; i < 16; ++i) {
                    const int ci = (i & 3) + 8 * (i >> 2);
                    const unsigned mm = (unsigned)__builtin_amdgcn_sbfe((int)mws, ci, 1);
                    x[i] = ex2(bfi_f(mm, x[i] * C_D64 + tp[ci], -INFINITY) - S);
                    l += x[i];
                }
            }
            const bf16x8 p0 = pack8(x, 0), p1 = pack8(x, 1);
            pv_tile<64, VSTR64>(acc, Vs, 32 * kt, p0, p1, lane);
        }
    }
    l = swap_sum(l);
    store_o_rows<64, KSTR64>(F, acc, 1.f / l, O + (size_t)(b * SEQ + t0) * DM + 1024 + h * 64, DM, Ks);
}

DI void store_o_rows_merge(Frame& F, const f32x16* acc, float m0v, float l0v, bf16* out0, const bf16* o1, const bf16* o2, const float* st, size_t tok0, int h, LAS unsigned char* buf) {
    constexpr int STR = KSTR128;
    int lane_ = F.lane; asm volatile("" : "+v"(lane_));
    const int tl = lane_ & 31, hf = lane_ >> 5;
    const float inv0 = 1.f / l0v;
    __syncthreads();
    LAS unsigned char* my = buf + F.wave * 32 * STR;
    LAS float* ml = (LAS float*)(buf + 8 * 32 * STR + F.wave * 256);
#pragma unroll
    for (int eb = 0; eb < 4; ++eb)
#pragma unroll
        for (int k = 0; k < 4; ++k) { u32x2 o; o.x = cvtpk(acc[eb][4 * k] * inv0, acc[eb][4 * k + 1] * inv0); o.y = cvtpk(acc[eb][4 * k + 2] * inv0, acc[eb][4 * k + 3] * inv0);
            *(LAS u32x2*)(my + tl * STR + (32 * eb + 8 * k + 4 * hf) * 2) = o; }
    if (hf == 0) { ml[2 * tl] = m0v; ml[2 * tl + 1] = l0v; }
    asm volatile("s_waitcnt lgkmcnt(0)" ::: "memory");
#pragma unroll
    for (int hb = 0; hb < 8; hb += 4) {
        u32x4 bq[4], cq[4]; float m1[4], s1[4], m2[4], s2[4];
#pragma unroll
        for (int k = 0; k < 4; ++k) { const int c = lane_ + 64 * (hb + k), r = c >> 4, q = c & 15;
            const size_t tok = tok0 + 32 * F.wave + r, off = tok * DM + h * 128 + q * 8, si = tok * 16 + h;
            bq[k] = *(const u32x4*)(o1 + off); cq[k] = *(const u32x4*)(o2 + off);
            m1[k] = st[(size_t)2 * MTOK * 16 + si]; s1[k] = st[(size_t)3 * MTOK * 16 + si]; m2[k] = st[(size_t)4 * MTOK * 16 + si]; s2[k] = st[(size_t)5 * MTOK * 16 + si]; }
#pragma unroll
        for (int k = 0; k < 4; ++k) { const int c = lane_ + 64 * (hb + k), r = c >> 4, q = c & 15;
            const u32x4 a = *(LAS const u32x4*)(my + r * STR + q * 16);
            const size_t off = (tok0 + 32 * F.wave + r) * DM + h * 128 + q * 8;
            const float m0 = ml[2 * r], s0 = ml[2 * r + 1];
            const float mm = fmaxf(m0, fmaxf(m1[k], m2[k]));
            float w0 = s0 * ex2(m0 - mm), w1 = s1[k] * ex2(m1[k] - mm), w2 = s2[k] * ex2(m2[k] - mm);
            const float inv = 1.f / (w0 + w1 + w2); w0 *= inv; w1 *= inv; w2 *= inv;
            u32x4 o;
#pragma unroll
            for (int e = 0; e < 4; ++e) {
                const unsigned ua = a[e], ub = bq[k][e], uc = cq[k][e];
                const float lo = w0 * __uint_as_float(ua << 16) + w1 * __uint_as_float(ub << 16) + w2 * __uint_as_float(uc << 16);
                const float hi = w0 * __uint_as_float(ua & 0xffff0000u) + w1 * __uint_as_float(ub & 0xffff0000u) + w2 * __uint_as_float(uc & 0xffff0000u);
                o[e] = cvtpk(lo, hi); }
            *(u32x4*)(out0 + off) = o; }
    }
}

struct DilItem { int g, b, h, r, nb; };
DI DilItem dil_item(int k) {
    DilItem it; int bh, sub;
    if (k < 1024) { it.g = 0; bh = k >> 4; sub = k & 15; }
    else { const int idx = k - 1024; bh = idx >> 5; it.g = 1 + ((idx >> 4) & 1); sub = idx & 15; }
    const int d = it.g == 0 ? 1 : (it.g == 1 ? 4 : 16), nbk = 16 / d;
    it.b = bh >> 4; it.h = bh & 15; it.r = sub / nbk; it.nb = sub % nbk; return it;
}
DI const bf16* dil_hm(Frame& F, int which, int b, int h, int pos) { return (const bf16*)(F.ws + WS_BIG) + (size_t)which * MTOK * 2048 + ((size_t)(b * 16 + h) * SEQ + pos) * 128; }
DI const bf16* dil_kptr(Frame& F, const DilItem& it, int st, size_t& gstr) {
    const int d = it.g == 0 ? 1 : (it.g == 1 ? 4 : 16); gstr = (size_t)d * 128;
    return dil_hm(F, 1, it.b, it.h, (256 * it.nb - 128 + 128 * st) * d + it.r);
}
DI void dil_unit(Frame& F, const DilItem& it, bool has_next, const DilItem& nx, RowRegs<128>& RK, RowRegs<128>& RV) {
    const int g = it.g, b = it.b, h = it.h, r = it.r, nb = it.nb;
    const bf16* H1 = (const bf16*)(F.ws + WS_BIG);
    bf16* O = g == 0 ? (bf16*)(F.ws + WS_XB) : (bf16*)(F.ws + WS_OG) + (size_t)(g - 1) * MTOK * DM;
    float* stM = (float*)(F.ws + WS_STAT) + (size_t)(2 * g) * MTOK * 16; float* stS = stM + (size_t)MTOK * 16;
    LAS unsigned char* Ks = F.lds + ATT_K_OFF; LAS unsigned char* Vs = F.lds + ATT_V_OFF;
    LAS float* tb = (LAS float*)(F.lds + ATT_TB_OFF);
    const int lane = F.lane, w = F.wave, tl = lane & 31, hf = lane >> 5;
    const int d = g == 0 ? 1 : (g == 1 ? 4 : 16);
    const int m0 = 256 * nb, iq = 32 * w + tl;
    const size_t tokq = (size_t)b * SEQ + (size_t)(m0 + iq) * d + r;
    __syncthreads();
    { const float* bd = (const float*)(F.ws + WS_BIASDIL) + (g * 16 + h) * 160;
      if (F.tid <= 128) tb[128 - F.tid] = bd[F.tid]; }
    bf16x8 qf[8];
    const size_t tok0 = (size_t)b * SEQ + (size_t)m0 * d + r;
    load_q_frags<128, KSTR128>(F, qf, dil_hm(F, 0, b, h, m0 * d + r), (size_t)d * 128, Ks);
    f32x16 acc[4];
#pragma unroll
    for (int e = 0; e < 4; ++e)
#pragma unroll
        for (int i = 0; i < 16; ++i) acc[e][i] = 0.f;
    float m = -1e30f, l = 0.f;
    const int st_lo = (nb == 0 ? 1 : 0);
    for (int st = st_lo; st < 3; ++st) {
        const int cbase = -128 + 128 * st;
        __syncthreads();
        put_rows128<128, KSTR128>(Ks, RK, F.tid); put_rows128<128, VSTR128>(Vs, RV, F.tid);
        __syncthreads();
        if (st < 2) { size_t gs; const bf16* kg = dil_kptr(F, it, st + 1, gs);
            fetch_rows128<128>(RK, kg, gs, F.tid); fetch_rows128<128>(RV, kg + (size_t)MTOK * 2048, gs, F.tid); }
        else if (has_next) { size_t gs; const bf16* kg = dil_kptr(F, nx, nx.nb == 0 ? 1 : 0, gs);
            fetch_rows128<128>(RK, kg, gs, F.tid); fetch_rows128<128>(RV, kg + (size_t)MTOK * 2048, gs, F.tid); }
#pragma unroll 1
        for (int kt = 0; kt < 4; ++kt) {
            const int c0 = cbase + 32 * kt;
            const int delta = 32 * w - c0;
            if (delta < 0 || delta > 128) continue;
            f32x16 x = st_tile<128, KSTR128>(Ks, 32 * kt, qf, tl, hf);
            const int jb = iq - c0 - 4 * hf;
            float mx = -1e30f;
            if (delta == 0 || delta == 128) {
                const unsigned mword = delta == 0 ? (0xffffffffu >> (31 - tl)) : (0xffffffffu << tl);
                const unsigned mws = mword >> (4 * hf);
                const LAS float* tp = tb + (128 - jb);
#pragma unroll
                for (int i = 0; i < 16; ++i) {
                    const int ci = (i & 3) + 8 * (i >> 2);
                    const unsigned mm = (unsigned)__builtin_amdgcn_sbfe((int)mws, ci, 1);
                    x[i] = bfi_f(mm, x[i] * C_D128 + tp[ci], -INFINITY);
                    mx = fmaxf(mx, x[i]);
                }
            } else {
                const LAS float* tp = tb + (128 - jb);
#pragma unroll
                for (int i = 0; i < 16; ++i) { const int ci = (i & 3) + 8 * (i >> 2); x[i] = x[i] * C_D128 + tp[ci]; mx = fmaxf(mx, x[i]); }
            }
            mx = swap_max(mx);
            const float mn = (mx > m + 8.f) ? mx : m, alpha = ex2(m - mn);
            float ps = 0.f;
#pragma unroll
            for (int i = 0; i < 16; ++i) { x[i] = ex2(x[i] - mn); ps += x[i]; }
            ps = swap_sum(ps);
            l = l * alpha + ps; m = mn;
            if (!__all(alpha == 1.f)) {
#pragma unroll
                for (int e = 0; e < 4; ++e)
#pragma unroll
                    for (int i = 0; i < 16; ++i) acc[e][i] *= alpha;
            }
            const bf16x8 p0 = pack8(x, 0), p1 = pack8(x, 1);
            pv_tile<128, VSTR128>(acc, Vs, 32 * kt, p0, p1, lane);
        }
    }
    if (g == 0) {
        store_o_rows_merge(F, acc, m, l, (bf16*)(F.ws + WS_XB), (const bf16*)(F.ws + WS_OG), (const bf16*)(F.ws + WS_OG) + (size_t)MTOK * DM, (const float*)(F.ws + WS_STAT), tok0, h, Ks);
    } else {
        store_o_rows<128, KSTR128>(F, acc, 1.f / l, O + tok0 * DM + h * 128, (size_t)d * DM, Ks);
        if (hf == 0) { stM[tokq * 16 + h] = m; stS[tokq * 16 + h] = l; }
    }
}

DI void phase_merge(Frame& F) {
    const int gw = F.bid * NWAVES + F.wave, NGW = F.G * NWAVES;
    bf16* o0 = (bf16*)(F.ws + WS_XB); const bf16* o1 = (const bf16*)(F.ws + WS_OG); const bf16* o2 = o1 + (size_t)MTOK * DM;
    const float* st = (const float*)(F.ws + WS_STAT);
    const int h = F.lane >> 2;
    for (int row = gw; row < MTOK; row += NGW) {
        const size_t si = (size_t)row * 16 + h, off = (size_t)row * DM + 32 * F.lane;
        u32x4 a[4], bq[4], c[4];
#pragma unroll
        for (int j = 0; j < 4; ++j) { a[j] = *(const u32x4*)(o0 + off + 8 * j); bq[j] = *(const u32x4*)(o1 + off + 8 * j); c[j] = *(const u32x4*)(o2 + off + 8 * j); }
        const float m0 = st[si], s0 = st[(size_t)MTOK * 16 + si], m1 = st[(size_t)2 * MTOK * 16 + si], s1 = st[(size_t)3 * MTOK * 16 + si],
                    m2 = st[(size_t)4 * MTOK * 16 + si], s2 = st[(size_t)5 * MTOK * 16 + si];
        const float mm = fmaxf(m0, fmaxf(m1, m2));
        float w0 = s0 * ex2(m0 - mm), w1 = s1 * ex2(m1 - mm), w2 = s2 * ex2(m2 - mm);
        const float inv = 1.f / (w0 + w1 + w2); w0 *= inv; w1 *= inv; w2 *= inv;
#pragma unroll
        for (int j = 0; j < 4; ++j) { u32x4 o;
#pragma unroll
            for (int q = 0; q < 4; ++q) {
                const unsigned ua = a[j][q], ub = bq[j][q], uc = c[j][q];
                const float lo = w0 * __uint_as_float(ua << 16) + w1 * __uint_as_float(ub << 16) + w2 * __uint_as_float(uc << 16);
                const float hi = w0 * __uint_as_float(ua & 0xffff0000u) + w1 * __uint_as_float(ub & 0xffff0000u) + w2 * __uint_as_float(uc & 0xffff0000u);
                o[q] = cvtpk(lo, hi); }
            *(u32x4*)(o0 + off + 8 * j) = o; }
    }
}

DI void phase_kmax(Frame& F) {
    const bf16* H0 = (const bf16*)(F.ws + WS_BIG); unsigned* kmax = (unsigned*)(F.ws + WS_KMAX);
    const int gw = F.bid * NWAVES + F.wave, NGW = F.G * NWAVES;
    for (int r8 = gw; r8 < MTOK / 8; r8 += NGW) {
        float best = 0.f;
#pragma unroll
        for (int k = 0; k < 8; ++k) {
            const bf16* p = H0 + (size_t)(r8 * 8 + k) * EVEN_LD + C_KB + 16 * F.lane;
            const u32x4 a = *(const u32x4*)p, b = *(const u32x4*)(p + 8);
            float ssq = 0.f;
#pragma unroll
            for (int q = 0; q < 4; ++q) { const float a0 = __uint_as_float(a[q] << 16), a1 = __uint_as_float(a[q] & 0xffff0000u), b0 = __uint_as_float(b[q] << 16), b1 = __uint_as_float(b[q] & 0xffff0000u);
                ssq += (a0 * a0 + a1 * a1) + (b0 * b0 + b1 * b1); }
            ssq += __shfl_xor(ssq, 1); ssq += __shfl_xor(ssq, 2);
            best = fmaxf(best, ssq);
        }
        if ((F.lane & 3) == 0) atomicMax(kmax + ((r8 * 8) >> 12) * 16 + (F.lane >> 2), __float_as_uint(best));
    }
}

DI int row_sum16(int x) {
    x += __builtin_amdgcn_update_dpp(0, x, 0xB1, 0xF, 0xF, true);
    x += __builtin_amdgcn_update_dpp(0, x, 0x4E, 0xF, 0xF, true);
    x += __builtin_amdgcn_update_dpp(0, x, 0x141, 0xF, 0xF, true);
    x += __builtin_amdgcn_update_dpp(0, x, 0x140, 0xF, 0xF, true);
    return x;
}
DI int wave_sum_i(int x) { x = row_sum16(x); return __builtin_amdgcn_readlane(x, 0) + __builtin_amdgcn_readlane(x, 16) + __builtin_amdgcn_readlane(x, 32) + __builtin_amdgcn_readlane(x, 48); }
DI int cnt4_ge(unsigned k0, unsigned k1, unsigned k2, unsigned k3, unsigned cand, int cl) {
    unsigned long long m0, m1, m2, m3;
    asm volatile("v_cmp_le_u32_e64 %1, %9, %5\n\tv_cmp_le_u32_e64 %2, %9, %6\n\tv_cmp_le_u32_e64 %3, %9, %7\n\tv_cmp_le_u32_e64 %4, %9, %8\n\t"
                 "v_addc_co_u32_e64 %0, %1, 0, %0, %1\n\tv_addc_co_u32_e64 %0, %2, 0, %0, %2\n\tv_addc_co_u32_e64 %0, %3, 0, %0, %3\n\tv_addc_co_u32_e64 %0, %4, 0, %0, %4"
                 : "+v"(cl), "=&s"(m0), "=&s"(m1), "=&s"(m2), "=&s"(m3) : "v"(k0), "v"(k1), "v"(k2), "v"(k3), "s"(cand));
    return cl;
}
DI unsigned f2ord(float f) { const unsigned u = __float_as_uint(f); return (u & 0x80000000u) ? ~u : (u | 0x80000000u); }
DI void index_unit(Frame& F, int b, int t0) {
    const bf16* H0 = (const bf16*)(F.ws + WS_BIG);
    unsigned long long* mask64 = (unsigned long long*)(F.ws + WS_MASK);
    LAS float* sc = (LAS float*)F.lds;
    const int lane = F.lane, w = F.wave, r = lane & 31, hf = lane >> 5;
    __syncthreads();
    const int rg = r >> 3, rhh = (r >> 2) & 1, rc = r & 3, a_tq = 2 * rhh + (rg >> 1), a_hd = 4 * (rg & 1) + rc;
    bf16x8 qa[2][4]; float wv[2][16];
#pragma unroll
    for (int mt = 0; mt < 2; ++mt) {
        const bf16* qp = H0 + (size_t)(b * SEQ + t0 + 4 * mt + a_tq) * EVEN_LD + C_QI + a_hd * 64 + 8 * hf;
#pragma unroll
        for (int st = 0; st < 4; ++st) qa[mt][st] = *(const bf16x8*)(qp + 16 * st);
#pragma unroll
        for (int q = 0; q < 2; ++q) {
            const bf16* wp = H0 + (size_t)(b * SEQ + t0 + 4 * mt + 2 * hf + q) * EVEN_LD + C_WI;
            const u32x4 wr = *(const u32x4*)wp;
#pragma unroll
            for (int k = 0; k < 4; ++k) { const unsigned u = wr[k]; wv[mt][8 * q + 2 * k] = bf2f((unsigned short)(u & 0xffff)) * 0.04419417382415922f; wv[mt][8 * q + 2 * k + 1] = bf2f((unsigned short)(u >> 16)) * 0.04419417382415922f; }
        }
    }
    const int nkt = (t0 + 8 + 31) >> 5;
    if (t0 + 8 > 256) for (int _r22 = 0; _r22 < (PROBE_PHASE == 22 ? 2 : 1); ++_r22) {
        bf16x8 kb[4], kn[4];
        { const bf16* kp = H0 + (size_t)(b * SEQ + 32 * w + r) * EVEN_LD + C_KI + 8 * hf;
          if (w < nkt) {
#pragma unroll
              for (int st = 0; st < 4; ++st) kb[st] = *(const bf16x8*)(kp + 16 * st); } }
        for (int kt = w; kt < nkt; kt += NWAVES) {
            const int s = 32 * kt + r;
            if (kt + NWAVES < nkt) { const bf16* kp = H0 + (size_t)(b * SEQ + s + 32 * NWAVES) * EVEN_LD + C_KI + 8 * hf;
#pragma unroll
                for (int st = 0; st < 4; ++st) kn[st] = *(const bf16x8*)(kp + 16 * st); }
#pragma unroll
            for (int mt = 0; mt < 2; ++mt) {
                f32x16 x;
#pragma unroll
                for (int i = 0; i < 16; ++i) x[i] = 0.f;
#pragma unroll
                for (int st = 0; st < 4; ++st) x = MFMA32(qa[mt][st], kb[st], x);
                float s0v = 0.f, s1v = 0.f;
#pragma unroll
                for (int i = 0; i < 8; ++i) { s0v += wv[mt][i] * fmaxf(x[i], 0.f); s1v += wv[mt][8 + i] * fmaxf(x[8 + i], 0.f); }
                const int tq0 = 4 * mt + 2 * hf;
                sc[tq0 * 4096 + s] = (s <= t0 + tq0) ? (s0v + 0.f) : -1e30f;
                sc[(tq0 + 1) * 4096 + s] = (s <= t0 + tq0 + 1) ? (s1v + 0.f) : -1e30f;
            }
#pragma unroll
            for (int st = 0; st < 4; ++st) kb[st] = kn[st];
        }
    }
    __syncthreads();
    const int t = t0 + w;
    unsigned long long myword = 0ull;
    for (int _r21 = 0; _r21 < (PROBE_PHASE == 21 ? 2 : 1); ++_r21)
    if (t < 256) {
        const int nbits = t + 1 - 64 * lane;
        myword = nbits >= 64 ? ~0ull : (nbits <= 0 ? 0ull : ((1ull << nbits) - 1ull));
    } else {
        unsigned key[64];
#pragma unroll
        for (int i = 0; i < 64; ++i) { const int s = 64 * i + lane; key[i] = (s <= t) ? f2ord(sc[w * 4096 + s]) : 0u; }
        unsigned res = 0u;
        const int nreg = (t >> 6) + 1;
#pragma unroll 1
        for (int bit = 31; bit >= 0; --bit) {
            const unsigned cand = res | (1u << bit);
            int cl = 0;
#pragma unroll
            for (int gq = 0; gq < 8; ++gq) if (8 * gq < nreg) {
#pragma unroll
                for (int i = 8 * gq; i < 8 * gq + 8; i += 4) cl = cnt4_ge(key[i], key[i + 1], key[i + 2], key[i + 3], cand, cl); }
            const int cnt = wave_sum_i(cl);
            if (cnt >= 256) { res = cand; if (cnt == 256) break; }
        }
        int need, eqc;
        { int cg_ = 0, ce_ = 0;
#pragma unroll
          for (int gq = 0; gq < 8; ++gq) if (8 * gq < nreg) {
#pragma unroll
              for (int i = 8 * gq; i < 8 * gq + 8; ++i) { cg_ += (key[i] > res) ? 1 : 0; ce_ += (key[i] == res) ? 1 : 0; } }
          need = 256 - wave_sum_i(cg_); eqc = wave_sum_i(ce_); }
        if (eqc == need) {
#pragma unroll
            for (int i = 0; i < 64; ++i) { const unsigned long long sb = __ballot(key[i] >= res);
                if (lane == i) myword = sb; }
        } else {
            const unsigned long long lt = (1ull << lane) - 1ull;
            int running = 0;
#pragma unroll
            for (int i = 0; i < 64; ++i) {
                const bool gtb = key[i] > res, eq = key[i] == res;
                const unsigned long long tbm = __ballot(eq);
                const int rank = running + __popcll(tbm & lt);
                const unsigned long long sb = __ballot(gtb || (eq && rank < need));
                if (lane == i) myword = sb;
                running += __popcll(tbm);
            }
        }
    }
    mask64[(size_t)(b * SEQ + t) * 64 + lane] = myword;
}

#define SNAKE_FOR(NITEMS, k) for (int _rd = 0, k; _rd * F.G < (NITEMS); ++_rd) if ((k = (_rd & 1) ? _rd * F.G + (F.G - 1 - F.bid) : _rd * F.G + F.bid) < (NITEMS))

#define XB_TMO      128
#define XB_XCNT(j)  (256  + 64 * (j))
#define XB_XSUB(j)  (1280 + 64 * (j))
#define XB_XGEN(j)  (2304 + 64 * (j))
#define XB_TOP      3328
#define XB_TOPGEN   3392
#define XCD_BAR_WORDS 3456
#define XB_SPIN_CAP (1u << 18)

__device__ __forceinline__ unsigned xb_ld(unsigned* p)              { return __hip_atomic_load(p, __ATOMIC_RELAXED, __HIP_MEMORY_SCOPE_AGENT); }
__device__ __forceinline__ unsigned xb_add(unsigned* p, unsigned v) { return __hip_atomic_fetch_add(p, v, __ATOMIC_RELAXED, __HIP_MEMORY_SCOPE_AGENT); }
__device__ __forceinline__ unsigned xb_xcc_id() { return (unsigned)__builtin_amdgcn_s_getreg((3 << 11) | 20) & 0xFu; }
#define XB_SPIN(cond, bar) do { unsigned _sp = 0; while (cond) { __builtin_amdgcn_s_sleep(1); \
    if ((++_sp & 255u) == 0u) { if (xb_ld(&(bar)[XB_TMO])) break; if (_sp > XB_SPIN_CAP) { atomicAdd(&(bar)[XB_TMO], 1u); break; } } } } while (0)

struct XcdBarrier {
    unsigned* bar; unsigned x;
    volatile LAS unsigned* st;
};

__device__ __forceinline__ XcdBarrier xcd_barrier_post(unsigned* bar, volatile LAS unsigned* st) {
    XcdBarrier b; b.bar = bar; b.x = xb_xcc_id(); b.st = st;
    if (threadIdx.x == 0) (void)xb_add(&bar[XB_XCNT(b.x)], 1u);
    return b;
}
__device__ __forceinline__ void xcd_barrier_complete(unsigned* bar, unsigned x, unsigned& nloc, unsigned& nx) {
    const unsigned G = gridDim.x * gridDim.y * gridDim.z;
    unsigned sum, cnt, mine, sp = 0u;
    for (;;) {
        sum = 0u; cnt = 0u; mine = 0u;
#pragma unroll
        for (unsigned j = 0; j < 16; ++j) { const unsigned c = xb_ld(&bar[XB_XCNT(j)]); sum += c; cnt += (c > 0u) ? 1u : 0u; mine = (j == x) ? c : mine; }
        if (sum == G) break;
        __builtin_amdgcn_s_sleep(1);
        if ((++sp & 255u) == 0u) { if (xb_ld(&bar[XB_TMO])) break; if (sp > XB_SPIN_CAP) { atomicAdd(&bar[XB_TMO], 1u); break; } }
    }
    nloc = mine > 0u ? mine : 1u; nx = cnt > 0u ? cnt : 1u;
}

__device__ __forceinline__ void xcd_barrier(const XcdBarrier& b) {
    asm volatile("s_waitcnt vmcnt(0)" ::: "memory");
    __syncthreads();
    if (threadIdx.x == 0) {
        unsigned* bar = b.bar;
        __builtin_amdgcn_s_waitcnt(0);
        unsigned nloc = b.st[0], nx = b.st[1];
        if (nloc == 0u) { xcd_barrier_complete(bar, b.x, nloc, nx); b.st[0] = nloc; b.st[1] = nx; }
        const unsigned old = xb_add(&bar[XB_XSUB(b.x)], 1u);
        const unsigned gen = old / nloc;
        if (old + 1u == (gen + 1u) * nloc) {
            __builtin_amdgcn_fence(__ATOMIC_RELEASE, "agent");
            asm volatile("s_waitcnt vmcnt(0)" ::: "memory");
            const unsigned og = xb_add(&bar[XB_TOP], 1u);
            const unsigned tg = og / nx;
            if (og + 1u == (tg + 1u) * nx) xb_add(&bar[XB_TOPGEN], 1u);
            else XB_SPIN(xb_ld(&bar[XB_TOPGEN]) == tg, bar);
            __builtin_amdgcn_fence(__ATOMIC_ACQUIRE, "agent");
            xb_add(&bar[XB_XGEN(b.x)], 1u);
            asm volatile("s_waitcnt vmcnt(0)" ::: "memory");
        } else {
            XB_SPIN(xb_ld(&bar[XB_XGEN(b.x)]) == gen, bar);
            __builtin_amdgcn_fence(__ATOMIC_ACQUIRE, "agent");
            asm volatile("s_waitcnt vmcnt(0)" ::: "memory");
        }
    }
    __syncthreads();
}

struct Args { const float* in[12]; float* out; unsigned char* ws; int ph_lo, ph_hi; };

DI void gemm_bf16(Frame& F, const bf16* A, const bf16* Bt, int N, int K, bf16* O, int ldc, bool sq) {
    pg8::Gemm g{A, Bt, MTOK, N, K}; pg8::StaticOrder S; S.init(MTOK, N, F.G, F.bid);
    if (sq) { pg8::EpiBf16<2> E{O, ldc}; pg8::gemm_phase<pg8::EpiBf16<2>, pg8::StaticOrder, PG8_ALIGN, PG8_SP2>((PG8_LAS unsigned char*)F.lds, g, S, E); }
    else { pg8::EpiBf16<0> E{O, ldc}; pg8::gemm_phase<pg8::EpiBf16<0>, pg8::StaticOrder, PG8_ALIGN, PG8_SP2>((PG8_LAS unsigned char*)F.lds, g, S, E); }
}
DI void gemm_res_ln(Frame& F, const bf16* A, const bf16* Bt, int K, float* out, const float* g, const float* b) {
    pg8::Gemm gm{A, Bt, MTOK, DM, K}; pg8::StaticOrder S; S.init(MTOK, DM, F.G, F.bid);
    pg8::EpiResLnF32 E{out, out, DM, DN_ALPHA, (const float*)(F.ws + WS_LNST), g, b};
    pg8::gemm_phase<pg8::EpiResLnF32, pg8::StaticOrder, PG8_ALIGN, PG8_SP2>((PG8_LAS unsigned char*)F.lds, gm, S, E);
}
DI void gemm_res(Frame& F, const bf16* A, const bf16* Bt, int K, const float* res, float* out) {
    pg8::Gemm g{A, Bt, MTOK, DM, K}; pg8::StaticOrder S; S.init(MTOK, DM, F.G, F.bid);
    pg8::EpiResF32 E{res, out, DM, DN_ALPHA};
    pg8::gemm_phase<pg8::EpiResF32, pg8::StaticOrder, PG8_ALIGN, PG8_SP2>((PG8_LAS unsigned char*)F.lds, g, S, E);
}

__global__ void __launch_bounds__(NTHR, 2) fwd(Args args) {
    extern __shared__ __attribute__((aligned(16))) unsigned char lds_raw[];
    Frame F;
    F.lds = (LAS unsigned char*)lds_raw;
    F.tid = threadIdx.x; F.lane = F.tid & 63; F.wave = __builtin_amdgcn_readfirstlane(F.tid >> 6);
    F.G = gridDim.x; F.bid = blockIdx.x;
#pragma unroll
    for (int i = 0; i < 12; ++i) F.in[i] = args.in[i];
    F.out = args.out; F.ws = args.ws;
    unsigned char* ws = args.ws;
    bf16* XB = (bf16*)(ws + WS_XB); bf16* BIG = (bf16*)(ws + WS_BIG);
    const bf16* WIN = (const bf16*)(ws + WS_WIN); const bf16* WOUT = (const bf16*)(ws + WS_WOUT);
    const bf16* W1 = (const bf16*)(ws + WS_W1); const bf16* W2 = (const bf16*)(ws + WS_W2);
    const int lo = args.ph_lo, hi = args.ph_hi;
#define IN(k) (lo <= (k) && (k) < hi)
#define SEAM(k) do { if (IN(k) && IN((k) + 1)) { if ((k) == 0) { cg::this_grid().sync(); bar = xcd_barrier_post(barw, MISC); } else { xcd_barrier(bar); } } } while (0)
    volatile LAS unsigned* MISC = (volatile LAS unsigned*)(F.lds + 131072 + 64);
    unsigned* barw = (unsigned*)ws;
    if (F.tid < 4) MISC[F.tid] = 0u;
    if (lo == 0 && F.bid == 0) for (int i = F.tid; i < XCD_BAR_WORDS; i += NTHR) barw[i] = 0u;
    __syncthreads();
    XcdBarrier bar; bar.bar = barw; bar.x = 0; bar.st = MISC;

    if (IN(0)) REPS(0) { prep_weights(F, 0); prep_misc(F); } SEAM(0);
    if (IN(1)) { gemm_bf16(F, XB, WIN, EVEN_LD, DM, BIG, EVEN_LD, false); if (PROBE_PHASE == 1) { __syncthreads(); gemm_bf16(F, XB, WIN, EVEN_LD, DM, BIG, EVEN_LD, false); } } SEAM(1);
    if (IN(2)) REPS(2) { phase_kmax(F); SNAKE_FOR(2048, k) { index_unit(F, k & 3, 8 * (511 - (k >> 2))); } } SEAM(2);
    if (IN(3)) {
        if (F.G == 256) {
            const int vcu3 = (F.bid % 8) * 32 + F.bid / 8, grp = vcu3 >> 4, j16 = vcu3 & 15, j8 = (j16 + 8) & 15;
#pragma unroll 1
            for (int rd = 0; rd < 4; ++rd) { const int bh = grp * 4 + rd; const int qb = rd == 0 ? 15 - j16 : (rd == 1 ? j16 : (rd == 2 ? 15 - j8 : j8));
                dsa_unit(F, bh >> 4, bh & 15, qb); }
            SNAKE_FOR(512, kk) { const int qb = 15 - (kk >> 5), bh = kk & 31; sb_unit(F, bh >> 3, bh & 7, qb); }
        } else {
        SNAKE_FOR(1024 + 512, k) {
            if (k < 1024) { const int qb = 15 - (k >> 6), bh = k & 63; dsa_unit(F, bh >> 4, bh & 15, qb); }
            else { const int kk = k - 1024; const int qb = 15 - (kk >> 5), bh = kk & 31; sb_unit(F, bh >> 3, bh & 7, qb); }
        }
        }
    } SEAM(3);
    if (IN(4)) { gemm_res(F, XB, WOUT, DM, F.in[0], F.out); } SEAM(4);
    if (IN(5)) { phase_ln(F, F.in[6], F.in[7], true); if (PROBE_PHASE == 99) { for (int q = 0; q < 20; ++q) xcd_barrier(bar); } } SEAM(5);
    if (IN(6)) { gemm_bf16(F, XB, W1, DFF, DM, BIG, DFF, true); } SEAM(6);
    if (IN(7)) { gemm_res_ln(F, BIG, W2, DFF, F.out, F.in[6], F.in[7]); } SEAM(7);
    if (IN(8)) { phase_ln(F, F.in[10], F.in[11], true); __syncthreads(); prep_weights(F, 1); } SEAM(8);
    if (IN(9)) { pg8::Gemm g{XB, WIN, MTOK, ODD_IN, DM}; pg8::StaticOrder S; S.init(MTOK, ODD_IN, F.G, F.bid); pg8::EpiBf16HeadMajor E{BIG};
        pg8::gemm_phase<pg8::EpiBf16HeadMajor, pg8::StaticOrder, PG8_ALIGN, PG8_SP2>((PG8_LAS unsigned char*)F.lds, g, S, E); } SEAM(9);
    const int vcu = (F.G % 8 == 0) ? (F.bid % 8) * (F.G / 8) + F.bid / 8 : F.bid;
#define DIL_RANGE(LO, HI) do { RowRegs<128> RK, RV; \
        if ((LO) + vcu < (HI)) { const DilItem it = dil_item((LO) + vcu); size_t gs; const bf16* kg = dil_kptr(F, it, it.nb == 0 ? 1 : 0, gs); \
            fetch_rows128<128>(RK, kg, gs, F.tid); fetch_rows128<128>(RV, kg + (size_t)MTOK * 2048, gs, F.tid); } \
        for (int k = (LO) + vcu; k < (HI); k += F.G) { \
            const DilItem it = dil_item(k); const bool hn = k + F.G < (HI); const DilItem nx = dil_item(hn ? k + F.G : k); \
            dil_unit(F, it, hn, nx, RK, RV); } } while (0)
    if (IN(10)) { DIL_RANGE(1024, 3072); } SEAM(10);
    if (IN(11)) { DIL_RANGE(0, 1024); } SEAM(11);
#undef DIL_RANGE
    if (IN(12)) { gemm_res_ln(F, XB, WOUT, DM, F.out, F.in[10], F.in[11]); } SEAM(12);
    if (IN(13)) { phase_ln(F, F.in[6] + DM, F.in[7] + DM, true); } SEAM(13);
    if (IN(14)) { gemm_bf16(F, XB, W1, DFF, DM, BIG, DFF, true); } SEAM(14);
    if (IN(15)) { gemm_res_ln(F, BIG, W2, DFF, F.out, F.in[6] + DM, F.in[7] + DM); } SEAM(15);
    if (IN(16)) { phase_ln(F, F.in[10] + DM, F.in[11] + DM, false); }
#undef IN
#undef SEAM
}

extern "C" void kernel_launch(void* const* d_in, const int* in_sizes, int n_in, void* d_out, int out_size, void* d_ws, size_t ws_size, hipStream_t stream) {
    static int grid = 0;
    if (grid == 0) {
        if (n_in != 12 || out_size != MTOK * DM || ws_size < WS_END) { fprintf(stderr, "kernel_launch: unexpected shapes (n_in %d out %d ws %zu)\n", n_in, out_size, ws_size); grid = -1; return; }
        int dev = 0, cus = 0, per_cu = 0;
        hipGetDevice(&dev); hipDeviceGetAttribute(&cus, hipDeviceAttributeMultiprocessorCount, dev);
        if (hipFuncSetAttribute((const void*)fwd, hipFuncAttributeMaxDynamicSharedMemorySize, LDS_BYTES) != hipSuccess) { fprintf(stderr, "kernel_launch: hipFuncSetAttribute failed\n"); grid = -1; return; }
        if (hipOccupancyMaxActiveBlocksPerMultiprocessor(&per_cu, (const void*)fwd, NTHR, LDS_BYTES) != hipSuccess || per_cu < 1) { fprintf(stderr, "kernel_launch: occupancy query says %d\n", per_cu); per_cu = 1; }
        (void)hipGetLastError();
        grid = cus * 1;
    }
    if (grid < 0) return;
    Args a{};
    for (int i = 0; i < 12; ++i) a.in[i] = (const float*)d_in[i];
    a.out = (float*)d_out; a.ws = (unsigned char*)d_ws;
#if MK_PER_PHASE
    for (int p = 0; p < N_PHASES; ++p) { a.ph_lo = p; a.ph_hi = p + 1; hipLaunchKernelGGL(fwd, dim3(grid), dim3(NTHR), LDS_BYTES, stream, a); }
#else
    a.ph_lo = 0; a.ph_hi = N_PHASES;
    void* kargs[] = {&a};
    hipError_t e = hipLaunchCooperativeKernel((const void*)fwd, dim3(grid), dim3(NTHR), kargs, LDS_BYTES, stream);
    if (e != hipSuccess) fprintf(stderr, "cooperative launch failed: %s (grid %d)\n", hipGetErrorString(e), grid);
#endif
}
```

```cpp
#include <hip/hip_runtime.h>
#include <hip/hip_cooperative_groups.h>
#include <cstdio>
#include <cstdint>
namespace cg = cooperative_groups;
namespace pg8 {
#define PG8_LAS __attribute__((address_space(3)))
typedef unsigned short bf16_t;
typedef short bf16x8 __attribute__((ext_vector_type(8)));
typedef float f32x4 __attribute__((ext_vector_type(4)));
typedef unsigned u32x4 __attribute__((ext_vector_type(4)));
constexpr int BM = 256, BK = 64, HALF = 128, HTB = HALF * BK * 2  , STAGE_BYTES = 8 * HTB, NXCD = 8, WGM = 8;

__host__ __device__ __forceinline__ int lds_byte(int r, int c) { const int st = (r >> 4) * 2 + (c >> 5), rr = r & 15, cc = c & 31, ob = rr * 64 + cc * 2; return st * 1024 + (ob ^ (((ob >> 9) & 1) << 5)); }
__host__ __device__ __forceinline__ void stage_rc(int b, int& R, int& C) { const int st = b / 1024, sb = b % 1024, swz = sb ^ (((sb >> 9) & 1) << 5); R = (st >> 1) * 16 + swz / 64; C = (st & 1) * 32 + (swz % 64) / 2; }
__host__ __device__ __forceinline__ int perm32(int rho) { const int n = rho >> 4, i = rho & 15; return 8 * (i >> 2) + 4 * n + (i & 3); }

struct Unit { int pm, pn; };
struct Gemm { const bf16_t* A; const bf16_t* Bt; int M, N, K; };

struct StaticOrder {
    int nM, nN, nwg, G, c;
    __host__ __device__ void init(int M, int N, int G_, int c_) { nM = M / BM; nN = N / BM; nwg = nM * nN; G = G_; c = c_; }
    __host__ __device__ bool next(int i, Unit& u) const {
        const long L = (long)i * G + c; if (L >= nwg) return false;
        int wgid = (int)L; { const int q = nwg / NXCD, r = nwg % NXCD, xcd = wgid % NXCD, off = wgid / NXCD; wgid = (xcd < r ? xcd * (q + 1) : r * (q + 1) + (xcd - r) * q) + off; }
        const int nig = WGM * nN, gid = wgid / nig, fm = gid * WGM, gsz = (nM - fm) < WGM ? (nM - fm) : WGM;
        u.pm = fm + ((wgid % nig) % gsz); u.pn = (wgid % nig) / gsz; return true;
    }
    __device__ __forceinline__ void a_ready(const Unit&) const {}
    __device__ __forceinline__ void done(const Unit&) const {}
};

__device__ __forceinline__ unsigned cvt_pk_bf16(float lo, float hi) { unsigned r; asm volatile("v_cvt_pk_bf16_f32 %0, %1, %2" : "=v"(r) : "v"(lo), "v"(hi)); return r; }
template <int ACT> struct EpiBf16 {
    static constexpr bool PERM = true, AFTER_DRAIN = false;
    bf16_t* O; int ldc;
    __device__ __forceinline__ void operator()(const f32x4 (&acc)[2][2][4][2], const Unit& u, int wr, int wc, int fr, int fq) const {
        const int row0 = u.pm * BM + wr * 64 + fr; const int col0 = u.pn * BM + wc * 32 + 8 * fq;
#pragma unroll
        for (int ai = 0; ai < 2; ++ai)
#pragma unroll
            for (int m = 0; m < 4; ++m) { bf16_t* rowp = O + (size_t)(row0 + ai * HALF + m * 16) * ldc + col0;
#pragma unroll
                for (int bj = 0; bj < 2; ++bj) { f32x4 v0 = acc[ai][bj][m][0], v1 = acc[ai][bj][m][1];
                    if (ACT == 2) {
#pragma unroll
                        for (int q = 0; q < 4; ++q) { float a = v0[q] > 0.f ? v0[q] : 0.f; v0[q] = a * a; float b = v1[q] > 0.f ? v1[q] : 0.f; v1[q] = b * b; } }
                    u32x4 w; w.x = cvt_pk_bf16(v0[0], v0[1]); w.y = cvt_pk_bf16(v0[2], v0[3]); w.z = cvt_pk_bf16(v1[0], v1[1]); w.w = cvt_pk_bf16(v1[2], v1[3]);
                    *(u32x4*)(rowp + bj * HALF) = w; } }
    }
};
struct EpiResF32 {
    static constexpr bool PERM = true, AFTER_DRAIN = false;
    const float* res; float* out; int ldc; float alpha;
    __device__ __forceinline__ void operator()(const f32x4 (&acc)[2][2][4][2], const Unit& u, int wr, int wc, int fr, int fq) const {
        const int row0 = u.pm * BM + wr * 64 + fr; const int col0 = u.pn * BM + wc * 32 + 8 * fq;
#pragma unroll
        for (int ai = 0; ai < 2; ++ai)
#pragma unroll
            for (int m = 0; m < 4; ++m) { const size_t off = (size_t)(row0 + ai * HALF + m * 16) * ldc + col0;
#pragma unroll
                for (int bj = 0; bj < 2; ++bj) { const size_t p = off + bj * HALF;
                    const f32x4 r0 = *(const f32x4*)(res + p), r1 = *(const f32x4*)(res + p + 4);
                    *(f32x4*)(out + p) = r0 * alpha + acc[ai][bj][m][0]; *(f32x4*)(out + p + 4) = r1 * alpha + acc[ai][bj][m][1]; } }
    }
};

struct EpiResLnF32 {
    static constexpr bool PERM = true, AFTER_DRAIN = false;
    const float* res; float* out; int ldc; float alpha; const float* stats; const float* g; const float* b;
    __device__ __forceinline__ void operator()(const f32x4 (&acc)[2][2][4][2], const Unit& u, int wr, int wc, int fr, int fq) const {
        const int row0 = u.pm * BM + wr * 64 + fr; const int col0 = u.pn * BM + wc * 32 + 8 * fq;
#pragma unroll
        for (int bj = 0; bj < 2; ++bj) {
            const f32x4 g0 = *(const f32x4*)(g + col0 + bj * HALF), g1 = *(const f32x4*)(g + col0 + bj * HALF + 4);
            const f32x4 b0 = *(const f32x4*)(b + col0 + bj * HALF), b1 = *(const f32x4*)(b + col0 + bj * HALF + 4);
#pragma unroll
            for (int ai = 0; ai < 2; ++ai)
#pragma unroll
                for (int m = 0; m < 4; ++m) { const int row = row0 + ai * HALF + m * 16; const size_t p = (size_t)row * ldc + col0 + bj * HALF;
                    const float mean = stats[2 * row], rstd = stats[2 * row + 1];
                    const f32x4 r0 = *(const f32x4*)(res + p), r1 = *(const f32x4*)(res + p + 4);
                    const f32x4 n0 = (r0 - mean) * rstd * g0 + b0, n1 = (r1 - mean) * rstd * g1 + b1;
                    *(f32x4*)(out + p) = n0 * alpha + acc[ai][bj][m][0]; *(f32x4*)(out + p + 4) = n1 * alpha + acc[ai][bj][m][1]; }
        }
    }
};

struct EpiBf16HeadMajor {
    static constexpr bool PERM = true, AFTER_DRAIN = false;
    bf16_t* O;
    __device__ __forceinline__ void operator()(const f32x4 (&acc)[2][2][4][2], const Unit& u, int wr, int wc, int fr, int fq) const {
        const int row0 = u.pm * BM + wr * 64 + fr; const int col0 = u.pn * BM + wc * 32 + 8 * fq;
#pragma unroll
        for (int bj = 0; bj < 2; ++bj) { const int col = col0 + bj * HALF; const int which = col >> 11, h = (col >> 7) & 15, e = col & 127;
            bf16_t* base = O + (size_t)which * (16384u * 2048u) + (size_t)h * (4096u * 128u) + e;
#pragma unroll
            for (int ai = 0; ai < 2; ++ai)
#pragma unroll
                for (int m = 0; m < 4; ++m) { const int row = row0 + ai * HALF + m * 16; const int bb = row >> 12, s = row & 4095;
                    const f32x4 v0 = acc[ai][bj][m][0], v1 = acc[ai][bj][m][1];
                    u32x4 w; w.x = cvt_pk_bf16(v0[0], v0[1]); w.y = cvt_pk_bf16(v0[2], v0[3]); w.z = cvt_pk_bf16(v1[0], v1[1]); w.w = cvt_pk_bf16(v1[2], v1[3]);
                    *(u32x4*)(base + ((size_t)bb * 16 * 4096 + s) * 128) = w; } }
    }
};
template <class Epi, class Sched, bool ALIGN_EPI = false, bool SP2 = false>
__device__ __forceinline__ void gemm_phase(PG8_LAS unsigned char* lds, const Gemm g, const Sched& S, const Epi& E) {
    const int tid = threadIdx.x, wid = __builtin_amdgcn_readfirstlane(tid >> 6), lane = tid & 63, wr = wid >> 2, wc = wid & 3, fr = lane & 15, fq = lane >> 4;
    const int K = g.K, nt = K / BK;
    unsigned voffA[2], voffB[2];
#pragma unroll
    for (int i = 0; i < 2; ++i) { int R, C; stage_rc(tid * 16 + i * 8192, R, C); const int Rb = Epi::PERM ? ((R & ~31) + perm32(R & 31)) : R;
        voffA[i] = (unsigned)(R * K + C) * 2u; voffB[i] = (unsigned)(Rb * K + C) * 2u; }
    const size_t kstep = (size_t)(BK * 2);
    const size_t hstep = (size_t)HALF * K * 2;
    const size_t tstep = 2 * hstep;
    const unsigned ldsw = (unsigned)wid * 1024u;
    const int aoff = lds_byte(wr * 64 + fr, fq * 8), boff = lds_byte(wc * 32 + fr, fq * 8);
#define PG8_SA(b, h) (((b) * 2 + (h)) * HTB)
#define PG8_SB(b, h) ((4 + (b) * 2 + (h)) * HTB)
#define PG8_STAGE(bufoff, gbase, voff) do { _Pragma("unroll") for (int _i = 0; _i < 2; ++_i) \
        __builtin_amdgcn_global_load_lds((const unsigned*)((const char*)(gbase) + (voff)[_i]), (PG8_LAS unsigned*)(lds + (bufoff) + ldsw + _i * 8192), 16, 0, 0); } while (0)
#define PG8_LDA(dst, b, h) do { _Pragma("unroll") for (int m = 0; m < 4; ++m) _Pragma("unroll") for (int k = 0; k < 2; ++k) dst[m][k] = *(const PG8_LAS bf16x8*)(lds + PG8_SA(b, h) + aoff + m * 2048 + k * 1024); } while (0)
#define PG8_LDB(dst, b, h) do { _Pragma("unroll") for (int n = 0; n < 2; ++n) _Pragma("unroll") for (int k = 0; k < 2; ++k) dst[n][k] = *(const PG8_LAS bf16x8*)(lds + PG8_SB(b, h) + boff + n * 2048 + k * 1024); } while (0)
#define PG8_MMA(ai, bj, At, Bt) do { __builtin_amdgcn_s_setprio(1); _Pragma("unroll") for (int m = 0; m < 4; ++m) _Pragma("unroll") for (int n = 0; n < 2; ++n) _Pragma("unroll") for (int k = 0; k < 2; ++k) \
        acc[ai][bj][m][n] = __builtin_amdgcn_mfma_f32_16x16x32_bf16(Bt[n][k], At[m][k], acc[ai][bj][m][n], 0, 0, 0); __builtin_amdgcn_s_setprio(0); } while (0)
#define PG8_WAIT_V(n) asm volatile("s_waitcnt vmcnt(" #n ")" ::: "memory")
#define PG8_WAIT_L(n) asm volatile("s_waitcnt lgkmcnt(" #n ")" ::: "memory")
#define PG8_BAR __builtin_amdgcn_s_barrier()
#define PG8_SCHED __builtin_amdgcn_sched_barrier(0)
    Unit cur, nxt; int ui = 0;
    if (!S.next(0, cur)) return;
    f32x4 acc[2][2][4][2];
#pragma unroll
    for (int a = 0; a < 2; ++a)
#pragma unroll
        for (int b = 0; b < 2; ++b)
#pragma unroll
            for (int m = 0; m < 4; ++m)
#pragma unroll
                for (int n = 0; n < 2; ++n) acc[a][b][m][n] = (f32x4){0.f, 0.f, 0.f, 0.f};
    bf16x8 At[4][2], B0[2][2], B1[2][2];
    const char* cA = (const char*)g.A + (size_t)cur.pm * tstep; const char* cB = (const char*)g.Bt + (size_t)cur.pn * tstep;
    S.a_ready(cur);
    if constexpr (SP2) {
        PG8_STAGE(PG8_SB(0, 0), cB, voffB); PG8_STAGE(PG8_SB(0, 1), cB + hstep, voffB); PG8_STAGE(PG8_SA(0, 0), cA, voffA); PG8_STAGE(PG8_SA(0, 1), cA + hstep, voffA);
        if (wr == 1) PG8_BAR;
        PG8_WAIT_V(2); PG8_BAR;
        PG8_STAGE(PG8_SB(1, 0), cB + kstep, voffB); PG8_STAGE(PG8_SA(1, 0), cA + kstep, voffA); PG8_STAGE(PG8_SB(1, 1), cB + hstep + kstep, voffB);
        PG8_WAIT_V(6); PG8_BAR;
    } else {
        PG8_STAGE(PG8_SB(0, 0), cB, voffB); PG8_STAGE(PG8_SA(0, 0), cA, voffA); PG8_STAGE(PG8_SB(0, 1), cB + hstep, voffB); PG8_STAGE(PG8_SA(0, 1), cA + hstep, voffA);
        if (wr == 1) PG8_BAR;
        PG8_WAIT_V(4); PG8_BAR;
        PG8_STAGE(PG8_SB(1, 0), cB + kstep, voffB); PG8_STAGE(PG8_SA(1, 0), cA + kstep, voffA); PG8_STAGE(PG8_SB(1, 1), cB + hstep + kstep, voffB);
        PG8_WAIT_V(6); PG8_BAR;
    }
    for (;;) {
        const bool has_next = S.next(ui + 1, nxt);
        const char* nA = has_next ? (const char*)g.A + (size_t)nxt.pm * tstep : cA; const char* nB = has_next ? (const char*)g.Bt + (size_t)nxt.pn * tstep : cB;
        for (int t = 0; t < nt; t += 2) {
            const bool last = (t == nt - 2);
            const char* a1 = cA + (size_t)(t + 1) * kstep;
            const char* a2 = last ? nA : cA + (size_t)(t + 2) * kstep; const char* b2 = last ? nB : cB + (size_t)(t + 2) * kstep;
            const char* a3 = a2 + kstep; const char* b3 = b2 + kstep;
            if (last && has_next) S.a_ready(nxt);
            if constexpr (SP2) {
            PG8_LDB(B0, 0, 0); PG8_LDB(B1, 0, 1); PG8_SCHED; PG8_LDA(At, 0, 0); PG8_STAGE(PG8_SA(1, 1), a1 + hstep, voffA);
            PG8_WAIT_V(8); PG8_WAIT_L(0); PG8_BAR; PG8_MMA(0, 0, At, B0); PG8_MMA(0, 1, At, B1); PG8_BAR; PG8_SCHED;
            PG8_LDA(At, 0, 1); PG8_STAGE(PG8_SB(0, 0), b2, voffB); PG8_STAGE(PG8_SB(0, 1), b2 + hstep, voffB); PG8_STAGE(PG8_SA(0, 0), a2, voffA);
            PG8_WAIT_V(8); PG8_WAIT_L(0); PG8_BAR; PG8_MMA(1, 0, At, B0); PG8_MMA(1, 1, At, B1); PG8_BAR; PG8_SCHED;
            PG8_LDB(B0, 1, 0); PG8_LDB(B1, 1, 1); PG8_SCHED; PG8_LDA(At, 1, 0); PG8_STAGE(PG8_SA(0, 1), a2 + hstep, voffA);
            PG8_WAIT_V(8); PG8_WAIT_L(0); PG8_BAR; PG8_MMA(0, 0, At, B0); PG8_MMA(0, 1, At, B1); PG8_BAR; PG8_SCHED;
            PG8_LDA(At, 1, 1); PG8_STAGE(PG8_SB(1, 0), b3, voffB); PG8_STAGE(PG8_SB(1, 1), b3 + hstep, voffB); PG8_STAGE(PG8_SA(1, 0), a3, voffA);
            PG8_WAIT_V(8); PG8_WAIT_L(0); PG8_BAR; PG8_MMA(1, 0, At, B0); PG8_MMA(1, 1, At, B1); PG8_BAR; PG8_SCHED;
            } else {
            PG8_LDB(B0, 0, 0); PG8_SCHED; PG8_LDA(At, 0, 0); PG8_STAGE(PG8_SA(1, 1), a1 + hstep, voffA);
            PG8_WAIT_L(8); PG8_BAR; PG8_WAIT_L(0); PG8_MMA(0, 0, At, B0); PG8_BAR; PG8_SCHED;
            PG8_LDB(B1, 0, 1); PG8_STAGE(PG8_SB(0, 0), b2, voffB);
            PG8_BAR; PG8_WAIT_L(0); PG8_MMA(0, 1, At, B1); PG8_BAR;
            PG8_LDA(At, 0, 1); PG8_STAGE(PG8_SA(0, 0), a2, voffA);
            PG8_BAR; PG8_WAIT_L(0); PG8_MMA(1, 0, At, B0); PG8_BAR; PG8_SCHED;
            PG8_STAGE(PG8_SB(0, 1), b2 + hstep, voffB);
            PG8_WAIT_V(6); PG8_BAR; PG8_MMA(1, 1, At, B1); PG8_BAR;
            PG8_LDB(B0, 1, 0); PG8_SCHED; PG8_LDA(At, 1, 0); PG8_STAGE(PG8_SA(0, 1), a2 + hstep, voffA);
            PG8_WAIT_L(8); PG8_BAR; PG8_WAIT_L(0); PG8_MMA(0, 0, At, B0); PG8_BAR; PG8_SCHED;
            PG8_LDB(B1, 1, 1); PG8_STAGE(PG8_SB(1, 0), b3, voffB);
            PG8_BAR; PG8_WAIT_L(0); PG8_MMA(0, 1, At, B1); PG8_BAR;
            PG8_LDA(At, 1, 1); PG8_STAGE(PG8_SA(1, 0), a3, voffA);
            PG8_BAR; PG8_WAIT_L(0); PG8_MMA(1, 0, At, B0); PG8_BAR; PG8_SCHED;
            PG8_STAGE(PG8_SB(1, 1), b3 + hstep, voffB);
            PG8_WAIT_V(6); PG8_BAR; PG8_MMA(1, 1, At, B1); PG8_BAR;
            }
        }
        if constexpr (ALIGN_EPI) { if (wr == 0) PG8_BAR; }
        if constexpr (!Epi::AFTER_DRAIN) { E(acc, cur, wr, wc, fr, fq); S.done(cur); }
        if (!has_next) break;
#pragma unroll
        for (int a = 0; a < 2; ++a)
#pragma unroll
            for (int b = 0; b < 2; ++b)
#pragma unroll
                for (int m = 0; m < 4; ++m)
#pragma unroll
                    for (int n = 0; n < 2; ++n) acc[a][b][m][n] = (f32x4){0.f, 0.f, 0.f, 0.f};
        cur = nxt; cA = nA; cB = nB; ++ui;
        if constexpr (ALIGN_EPI) { if (wr == 1) PG8_BAR; }
    }
    PG8_WAIT_V(0);
    if constexpr (!ALIGN_EPI) { if (wr == 0) PG8_BAR; }
    PG8_BAR;
    if constexpr (Epi::AFTER_DRAIN) { E.fused(acc, cur, wr, wc, fr, fq, lds, wid, lane); S.done(cur); }
#undef PG8_SA
#undef PG8_SB
#undef PG8_STAGE
#undef PG8_LDA
#undef PG8_LDB
#undef PG8_MMA
#undef PG8_WAIT_V
#undef PG8_WAIT_L
#undef PG8_BAR
#undef PG8_SCHED
}
}

constexpr int BATCH = 4, SEQ = 4096, DM = 2048, MTOK = BATCH * SEQ;
constexpr int EVEN_IN = 6728, EVEN_LD = 6912, ODD_IN = 6144, DFF = 8192;
constexpr int NWAVES = 8, NTHR = NWAVES * 64;
constexpr float DN_ALPHA = 1.4142135623730951f, LN_EPS = 1e-5f, LOG2E = 1.4426950408889634f;
constexpr float C_D128 = 0.08838834764831845f * LOG2E, C_D64 = 0.125f * LOG2E;
constexpr int C_QA = 0, C_KA = 1024, C_VA = 2048, C_QB = 3072, C_KB = 4096, C_VB = 5120, C_QI = 6144, C_KI = 6656, C_WI = 6720;
#ifndef MK_PER_PHASE
#define MK_PER_PHASE 0
#endif
constexpr int N_PHASES = 17;
#ifndef PG8_ALIGN
#define PG8_ALIGN true
#endif
#ifndef PG8_SP2
#define PG8_SP2 true
#endif
#ifndef PROBE_PHASE
#define PROBE_PHASE -1
#endif
#define REPS(k) for (int _rep = 0; _rep < ((PROBE_PHASE) == (k) ? 2 : 1); ++_rep)

constexpr size_t MiB = 1u << 20;
constexpr size_t WS_BIASD = 1 * MiB;
constexpr size_t WS_BIASDIL = 1 * MiB + 512 * 1024;
constexpr size_t WS_MASK = 2 * MiB;
constexpr size_t WS_STAT = 10 * MiB;
constexpr size_t WS_KMAX = 1 * MiB + 768 * 1024;
constexpr size_t WS_LNST = 17 * MiB;
constexpr size_t WS_WIN = 20 * MiB, WS_WOUT = 47 * MiB, WS_W1 = 55 * MiB, WS_W2 = 87 * MiB;
constexpr size_t WS_XB = 120 * MiB;
constexpr size_t WS_BIG = 184 * MiB;
constexpr size_t WS_OG = WS_BIG + 192 * MiB;
constexpr size_t WS_END = 504 * MiB;

constexpr int LDS_BYTES = 147456;

#define LAS __attribute__((address_space(3)))
typedef unsigned short bf16;
typedef short bf16x8 __attribute__((ext_vector_type(8)));
typedef short s16x4 __attribute__((ext_vector_type(4)));
typedef float f32x4 __attribute__((ext_vector_type(4)));
typedef float f32x16 __attribute__((ext_vector_type(16)));
typedef unsigned u32x4 __attribute__((ext_vector_type(4)));
typedef unsigned u32x2 __attribute__((ext_vector_type(2)));
typedef float f32x2_t __attribute__((ext_vector_type(2)));
typedef __bf16 bf16x2_t __attribute__((ext_vector_type(2)));
typedef short v4i16_t __attribute__((ext_vector_type(4)));
#define DI __device__ __forceinline__
#define MFMA32(a, b, c) __builtin_amdgcn_mfma_f32_32x32x16_bf16((a), (b), (c), 0, 0, 0)

DI unsigned cvtpk(float lo, float hi) { f32x2_t v = {lo, hi}; bf16x2_t b = __builtin_convertvector(v, bf16x2_t); return __builtin_bit_cast(unsigned, b); }
DI float bf2f(unsigned short h) { return __uint_as_float(((unsigned)h) << 16); }
DI int crow(int i, int h) { return (i & 3) + 8 * (i >> 2) + 4 * h; }
DI float ex2(float x) { return __builtin_amdgcn_exp2f(x); }
DI float lg2(float x) { return __builtin_amdgcn_logf(x); }
DI float swap_max(float m) { auto rr = __builtin_amdgcn_permlane32_swap(__float_as_uint(m), __float_as_uint(m), false, false); return fmaxf(__uint_as_float(rr[0]), __uint_as_float(rr[1])); }
DI float swap_sum(float m) { auto rr = __builtin_amdgcn_permlane32_swap(__float_as_uint(m), __float_as_uint(m), false, false); return __uint_as_float(rr[0]) + __uint_as_float(rr[1]); }
DI float swap_other(float m, int hf) { auto rr = __builtin_amdgcn_permlane32_swap(__float_as_uint(m), __float_as_uint(m), false, false); return hf ? __uint_as_float(rr[0]) : __uint_as_float(rr[1]); }
DI bf16x8 pack8(const f32x16& x, int s) {
    u32x4 p; p.x = cvtpk(x[8 * s], x[8 * s + 1]); p.y = cvtpk(x[8 * s + 2], x[8 * s + 3]); p.z = cvtpk(x[8 * s + 4], x[8 * s + 5]); p.w = cvtpk(x[8 * s + 6], x[8 * s + 7]);
    return __builtin_bit_cast(bf16x8, p);
}
DI s16x4 vtr(LAS const char* p) { return __builtin_bit_cast(s16x4, __builtin_amdgcn_ds_read_tr16_b64_v4i16((LAS v4i16_t*)p)); }
DI int rel_bucket(int d) {
    if (d < 16) return d;
    const float df = (float)d;
    int large = 16 + (int)(logf(df / 16.f) / 4.852030263919617f * 16.f);
    return large < 31 ? large : 31;
}

struct Frame {
    LAS unsigned char* lds;
    int tid, lane, wave, G, bid;
    const float* in[12]; float* out; unsigned char* ws;
};

DI void transpose_item(const float* W, int K, int N, bf16* WT, LAS float* scr, int item, int nblk, int lane) {
    const int kb = item / nblk, nb = item % nblk, k0 = 64 * kb, n0 = 32 * nb;
    const int nn = n0 + (lane & 31);
    float wreg[32];
#pragma unroll
    for (int i = 0; i < 32; ++i) { const int kk = 2 * i + (lane >> 5); wreg[i] = (nn < N) ? __builtin_nontemporal_load(W + (size_t)(k0 + kk) * N + nn) : 0.f; }
#pragma unroll
    for (int i = 0; i < 32; ++i) { const int kk = 2 * i + (lane >> 5); scr[kk * 33 + (lane & 31)] = wreg[i]; }
    asm volatile("s_waitcnt lgkmcnt(0)" ::: "memory");
    const int c = lane & 7;
#pragma unroll
    for (int j = 0; j < 4; ++j) { const int n = (lane >> 3) + 8 * j; const LAS float* s = scr + (8 * c) * 33 + n;
        u32x4 o; o.x = cvtpk(s[0 * 33], s[1 * 33]); o.y = cvtpk(s[2 * 33], s[3 * 33]); o.z = cvtpk(s[4 * 33], s[5 * 33]); o.w = cvtpk(s[6 * 33], s[7 * 33]);
        *(u32x4*)(WT + (size_t)(n0 + n) * K + k0 + 8 * c) = o; }
    asm volatile("s_waitcnt lgkmcnt(0)" ::: "memory");
}

DI void prep_weights(Frame& F, int layer) {
    LAS float* scr = (LAS float*)(F.lds + F.wave * 16384);
    const int gw = F.bid * NWAVES + F.wave, NGW = F.G * NWAVES;
    const float* Win = layer == 0 ? F.in[1] : F.in[3];
    const float* Wout = layer == 0 ? F.in[2] : F.in[4];
    const float* W1 = F.in[8] + (size_t)layer * DM * DFF;
    const float* W2 = F.in[9] + (size_t)layer * DFF * DM;
    const int Nin = layer == 0 ? EVEN_IN : ODD_IN, Npad = layer == 0 ? EVEN_LD : ODD_IN;
    const int nb_in = Npad / 32;
    const int I_IN = (DM / 64) * nb_in, I_OUT = (DM / 64) * (DM / 32), I_1 = (DM / 64) * (DFF / 32), I_2 = (DFF / 64) * (DM / 32);
    const int NIT = I_IN + I_OUT + I_1 + I_2;
    for (int it = gw; it < NIT; it += NGW) {
        int r = it;
        if (r < I_IN) { transpose_item(Win, DM, Nin, (bf16*)(F.ws + WS_WIN), scr, r, nb_in, F.lane); continue; } r -= I_IN;
        if (r < I_OUT) { transpose_item(Wout, DM, DM, (bf16*)(F.ws + WS_WOUT), scr, r, DM / 32, F.lane); continue; } r -= I_OUT;
        if (r < I_1) { transpose_item(W1, DM, DFF, (bf16*)(F.ws + WS_W1), scr, r, DFF / 32, F.lane); continue; } r -= I_1;
        transpose_item(W2, DFF, DM, (bf16*)(F.ws + WS_W2), scr, r, DM / 32, F.lane);
    }
}

DI void prep_misc(Frame& F) {
    const size_t gt = (size_t)F.bid * NTHR + F.tid, NT = (size_t)F.G * NTHR;
    const float* x = F.in[0]; bf16* xb = (bf16*)(F.ws + WS_XB);
#pragma unroll 4
    for (size_t i = gt; i < (size_t)MTOK * DM / 8; i += NT) {
        const f32x4 a = *(const f32x4*)(x + i * 8), b = *(const f32x4*)(x + i * 8 + 4);
        u32x4 o; o.x = cvtpk(a[0], a[1]); o.y = cvtpk(a[2], a[3]); o.z = cvtpk(b[0], b[1]); o.w = cvtpk(b[2], b[3]);
        *(u32x4*)(xb + i * 8) = o;
    }
    const float* rb = F.in[5];
    float* bd = (float*)(F.ws + WS_BIASD);
    for (size_t i = gt; i < 16 * 4096; i += NT) { const int h = (int)(i >> 12), d = (int)(i & 4095); bd[i] = rb[rel_bucket(d) * 16 + h] * LOG2E; }
    if (gt < 64) ((unsigned*)(F.ws + WS_KMAX))[gt] = 0u;
    if (gt < 16) { float bm = -1e30f; for (int k = 0; k < 32; ++k) bm = fmaxf(bm, rb[k * 16 + (int)gt]); ((float*)(F.ws + WS_KMAX + 256))[gt] = bm * LOG2E; }
    float* bdl = (float*)(F.ws + WS_BIASDIL);
    for (size_t i = gt; i < 3 * 16 * 160; i += NT) { const int g = (int)(i / (16 * 160)), rem = (int)(i % (16 * 160)), h = rem / 160, j = rem % 160;
        const int dil = g == 0 ? 1 : (g == 1 ? 4 : 16); const int dist = (j <= 128 ? j : 128) * dil;
        bdl[i] = rb[rel_bucket(dist) * 16 + h] * LOG2E; }
}

DI float wave_sum(float v) {
#pragma unroll
    for (int o = 1; o < 64; o <<= 1) v += __shfl_xor(v, o);
    return v;
}
DI void phase_ln(Frame& F, const float* g, const float* b, bool lazy) {
    const int gw = F.bid * NWAVES + F.wave, NGW = F.G * NWAVES;
    bf16* xb = (bf16*)(F.ws + WS_XB); float* lnst = (float*)(F.ws + WS_LNST);
    f32x4 gv[8], bv[8];
#pragma unroll
    for (int j = 0; j < 8; ++j) { gv[j] = *(const f32x4*)(g + 256 * j + 4 * F.lane); bv[j] = *(const f32x4*)(b + 256 * j + 4 * F.lane); }
    f32x4 vn[8];
    if (gw < MTOK) {
#pragma unroll
        for (int j = 0; j < 8; ++j) vn[j] = *(const f32x4*)(F.out + (size_t)gw * DM + 4 * F.lane + 256 * j); }
    for (int row = gw; row < MTOK; row += NGW) {
        float* xr = F.out + (size_t)row * DM + 4 * F.lane;
        f32x4 v[8]; float s = 0.f;
#pragma unroll
        for (int j = 0; j < 8; ++j) { v[j] = vn[j]; s += (v[j][0] + v[j][1]) + (v[j][2] + v[j][3]); }
        if (row + NGW < MTOK) {
#pragma unroll
            for (int j = 0; j < 8; ++j) vn[j] = *(const f32x4*)(xr + (size_t)NGW * DM + 256 * j); }
        const float mean = wave_sum(s) * (1.f / DM); float s2 = 0.f;
#pragma unroll
        for (int j = 0; j < 8; ++j) { v[j] = v[j] - mean; s2 += (v[j][0] * v[j][0] + v[j][1] * v[j][1]) + (v[j][2] * v[j][2] + v[j][3] * v[j][3]); }
        const float rstd = 1.f / sqrtf(wave_sum(s2) * (1.f / DM) + LN_EPS);
        if (lazy && F.lane == 0) { lnst[2 * row] = mean; lnst[2 * row + 1] = rstd; }
#pragma unroll
        for (int j = 0; j < 8; ++j) { const f32x4 y = v[j] * rstd * gv[j] + bv[j];
            if (lazy) { u32x2 o; o.x = cvtpk(y[0], y[1]); o.y = cvtpk(y[2], y[3]); *(u32x2*)(xb + (size_t)row * DM + 256 * j + 4 * F.lane) = o; }
            else __builtin_nontemporal_store(y, (f32x4*)(xr + 256 * j)); }
    }
}

template <int D> struct RowRegs { u32x4 v[128 * (D / 8) / NTHR]; };
template <int D>
DI void fetch_rows128(RowRegs<D>& R, const bf16* g0, size_t gstride, int tid) {
    constexpr int CPR = D / 8, NCH = 128 * CPR / NTHR;
#pragma unroll
    for (int k = 0; k < NCH; ++k) { const int c = tid + k * NTHR, r = c / CPR, q = c % CPR; R.v[k] = *(const u32x4*)(g0 + (size_t)r * gstride + q * 8); }
}
template <int D, int STR>
DI void put_rows128(LAS unsigned char* dst, const RowRegs<D>& R, int tid) {
    constexpr int CPR = D / 8, NCH = 128 * CPR / NTHR;
#pragma unroll
    for (int k = 0; k < NCH; ++k) { const int c = tid + k * NTHR, r = c / CPR, q = c % CPR; *(LAS u32x4*)(dst + r * STR + q * 16) = R.v[k]; }
}
template <int D, int STR>
DI f32x16 st_tile(LAS const unsigned char* Ks, int krow0, const bf16x8* qf, int tl, int hf) {
    f32x16 x;
#pragma unroll
    for (int i = 0; i < 16; ++i) x[i] = 0.f;
    LAS const unsigned char* kp = Ks + (krow0 + tl) * STR + hf * 16;
#pragma unroll
    for (int st = 0; st < D / 16; ++st) { const bf16x8 kf = *(LAS const bf16x8*)(kp + st * 32); x = MFMA32(kf, qf[st], x); }
    return x;
}
template <int D, int STR>
DI void pv_tile(f32x16* acc, LAS const unsigned char* Vs, int vrow0, bf16x8 p0, bf16x8 p1, int lane) {
    const int hf = lane >> 5, q = (lane & 15) >> 2, p = lane & 3, blk = (lane >> 4) & 1;
    LAS const char* vb = (LAS const char*)Vs + (vrow0 + 4 * hf + q) * STR + blk * 32 + p * 8;
#pragma unroll
    for (int eb = 0; eb < D / 32; ++eb) {
        const s16x4 l0 = vtr(vb + eb * 64), h0 = vtr(vb + 8 * STR + eb * 64);
        const s16x4 l1 = vtr(vb + 16 * STR + eb * 64), h1 = vtr(vb + 24 * STR + eb * 64);
        const bf16x8 v0 = __builtin_shufflevector(l0, h0, 0, 1, 2, 3, 4, 5, 6, 7), v1 = __builtin_shufflevector(l1, h1, 0, 1, 2, 3, 4, 5, 6, 7);
        acc[eb] = MFMA32(v0, p0, acc[eb]); acc[eb] = MFMA32(v1, p1, acc[eb]);
    }
}
template <int D>
DI void store_ot(const f32x16* acc, float inv, bf16* orow, int hf) {
#pragma unroll
    for (int eb = 0; eb < D / 32; ++eb)
#pragma unroll
        for (int k = 0; k < 4; ++k) { u32x2 o; o.x = cvtpk(acc[eb][4 * k] * inv, acc[eb][4 * k + 1] * inv); o.y = cvtpk(acc[eb][4 * k + 2] * inv, acc[eb][4 * k + 3] * inv);
            *(u32x2*)(orow + 32 * eb + 8 * k + 4 * hf) = o; }
}

template <int D, int STR>
DI void load_q_frags(Frame& F, bf16x8* qf, const bf16* g0, size_t gstride, LAS unsigned char* buf) {
    constexpr int CPR = D / 8, NCH = 256 * CPR / NTHR;
    __syncthreads();
    int tid_ = F.tid; asm volatile("" : "+v"(tid_));
#pragma unroll
    for (int hb = 0; hb < NCH; hb += 4) { u32x4 v[4];
#pragma unroll
      for (int k = 0; k < 4; ++k) { const int c = tid_ + (hb + k) * NTHR, r = c / CPR, q = c % CPR; v[k] = *(const u32x4*)(g0 + (size_t)r * gstride + q * 8); }
#pragma unroll
      for (int k = 0; k < 4; ++k) { const int c = tid_ + (hb + k) * NTHR, r = c / CPR, q = c % CPR; *(LAS u32x4*)(buf + r * STR + q * 16) = v[k]; } }
    __syncthreads();
    int lane_ = F.lane; asm volatile("" : "+v"(lane_));
    LAS const unsigned char* qp = buf + (32 * F.wave + (lane_ & 31)) * STR + 16 * (lane_ >> 5);
#pragma unroll
    for (int st = 0; st < D / 16; ++st) qf[st] = *(LAS const bf16x8*)(qp + 32 * st);
}
template <int D, int STR>
DI void store_o_rows(Frame& F, const f32x16* acc, float inv, bf16* o0, size_t gstride, LAS unsigned char* buf) {
    constexpr int CPR = D / 8, NCH = 32 * CPR / 64;
    int lane_ = F.lane; asm volatile("" : "+v"(lane_));
    const int tl = lane_ & 31, hf = lane_ >> 5;
    __syncthreads();
    LAS unsigned char* my = buf + F.wave * 32 * STR;
#pragma unroll
    for (int eb = 0; eb < D / 32; ++eb)
#pragma unroll
        for (int k = 0; k < 4; ++k) { u32x2 o; o.x = cvtpk(acc[eb][4 * k] * inv, acc[eb][4 * k + 1] * inv); o.y = cvtpk(acc[eb][4 * k + 2] * inv, acc[eb][4 * k + 3] * inv);
            *(LAS u32x2*)(my + tl * STR + (32 * eb + 8 * k + 4 * hf) * 2) = o; }
    asm volatile("s_waitcnt lgkmcnt(0)" ::: "memory");
#pragma unroll
    for (int i = 0; i < NCH; ++i) { const int c = lane_ + 64 * i, r = c / CPR, q = c % CPR;
        const u32x4 v = *(LAS const u32x4*)(my + r * STR + q * 16);
        *(u32x4*)(o0 + (size_t)(32 * F.wave + r) * gstride + q * 8) = v; }
}

constexpr int KSTR128 = 272, VSTR128 = 288, KSTR64 = 144, VSTR64 = 144;
constexpr int ATT_K_OFF = 0, ATT_V_OFF = 36864, ATT_TB_OFF = 73728, ATT_FLAG_OFF = 73728 + 16384;

DI void sb_unit(Frame& F, int b, int h, int qb) {
    const bf16* H0 = (const bf16*)(F.ws + WS_BIG); bf16* O = (bf16*)(F.ws + WS_XB);
    LAS unsigned char* Ks = F.lds + ATT_K_OFF; LAS unsigned char* Vs = F.lds + ATT_V_OFF;
    volatile LAS int* flags = (volatile LAS int*)(F.lds + ATT_FLAG_OFF);
    const int lane = F.lane, w = F.wave, tl = lane & 31, hf = lane >> 5;
    const int t0 = 256 * qb, tw = t0 + 32 * w, t = tw + tl;
    __syncthreads();
    if (F.tid < 8) flags[F.tid] = 0;
    bf16x8 qf[8];
    load_q_frags<128, KSTR128>(F, qf, H0 + (size_t)(b * SEQ + t0) * EVEN_LD + C_QA + h * 128, EVEN_LD, Ks);
    f32x16 acc[4];
#pragma unroll
    for (int e = 0; e < 4; ++e)
#pragma unroll
        for (int i = 0; i < 16; ++i) acc[e][i] = 0.f;
    float carry = 0.f; bool wdone = false;
    RowRegs<128> RK, RV;
    const int jtop = (t0 + 255) >> 7;
    { const bf16* kg = H0 + (size_t)(b * SEQ + 128 * jtop) * EVEN_LD + C_KA + h * 128;
      fetch_rows128<128>(RK, kg, EVEN_LD, F.tid); fetch_rows128<128>(RV, kg + (C_VA - C_KA), EVEN_LD, F.tid); }
    for (int j = jtop; j >= 0; --j) {
        __syncthreads();
        { int alld = 1;
#pragma unroll
          for (int k = 0; k < 8; ++k) alld &= flags[k];
          if (alld) break; }
        put_rows128<128, KSTR128>(Ks, RK, F.tid); put_rows128<128, VSTR128>(Vs, RV, F.tid);
        __syncthreads();
        if (j > 0) { const bf16* kg = H0 + (size_t)(b * SEQ + 128 * (j - 1)) * EVEN_LD + C_KA + h * 128;
            fetch_rows128<128>(RK, kg, EVEN_LD, F.tid); fetch_rows128<128>(RV, kg + (C_VA - C_KA), EVEN_LD, F.tid); }
        if (!wdone) {
#pragma unroll 1
            for (int kt = 3; kt >= 0; --kt) {
                const int s0 = 128 * j + 32 * kt;
                if (s0 > tw) continue;
                f32x16 x = st_tile<128, KSTR128>(Ks, 32 * kt, qf, tl, hf);
                float lk[16];
#pragma unroll
                for (int i = 0; i < 16; ++i) {
                    const int s = s0 + crow(i, hf);
                    const float z2 = x[i] * C_D128;
                    const float e = ex2(-fabsf(z2));
                    const float L2 = fmaxf(-z2, 0.f) + lg2(1.f + e);
                    const bool valid = s < t;
                    lk[i] = valid ? (-z2 - L2) : 0.f;
                    x[i] = valid ? -L2 : -1e30f;
                }
                float gs[4], pg[4];
#pragma unroll
                for (int k = 0; k < 4; ++k) { gs[k] = (lk[4 * k] + lk[4 * k + 1]) + (lk[4 * k + 2] + lk[4 * k + 3]); pg[k] = swap_other(gs[k], hf); }
                float above[4];
                { float run = 0.f;
#pragma unroll
                  for (int k = 3; k >= 0; --k) { above[k] = run + (hf == 0 ? pg[k] : 0.f); run += gs[k] + pg[k]; }
                  const float base = carry; carry += run;
#pragma unroll
                  for (int k = 0; k < 4; ++k) {
                      const float a3 = base + above[k];
                      const float a2 = a3 + lk[4 * k + 3], a1 = a2 + lk[4 * k + 2], a0 = a1 + lk[4 * k + 1];
                      x[4 * k + 3] = ex2(x[4 * k + 3] + a3); x[4 * k + 2] = ex2(x[4 * k + 2] + a2);
                      x[4 * k + 1] = ex2(x[4 * k + 1] + a1); x[4 * k] = ex2(x[4 * k] + a0);
                  } }
                const bf16x8 p0 = pack8(x, 0), p1 = pack8(x, 1);
                pv_tile<128, VSTR128>(acc, Vs, 32 * kt, p0, p1, lane);
            }
            wdone = __all(carry < -200.f);
            if (wdone && lane == 0) flags[w] = 1;
        }
    }
    store_o_rows<128, KSTR128>(F, acc, 1.f, O + (size_t)(b * SEQ + t0) * DM + h * 128, DM, Ks);
}

DI float bfi_f(unsigned m, float a, float b) { return __uint_as_float((__float_as_uint(a) & m) | (__float_as_uint(b) & ~m)); }
DI void dsa_unit(Frame& F, int b, int h, int qb) {
    const bf16* H0 = (const bf16*)(F.ws + WS_BIG); bf16* O = (bf16*)(F.ws + WS_XB);
    const unsigned* mask = (const unsigned*)(F.ws + WS_MASK);
    LAS unsigned char* Ks = F.lds + ATT_K_OFF; LAS unsigned char* Vs = F.lds + ATT_V_OFF;
    LAS float* tb = (LAS float*)(F.lds + ATT_TB_OFF);
    const int lane = F.lane, w = F.wave, tl = lane & 31, hf = lane >> 5;
    const int t0 = 256 * qb, tw = t0 + 32 * w, t = tw + tl;
    __syncthreads();
    { const float* bd = (const float*)(F.ws + WS_BIASD) + h * 4096;
      for (int i = F.tid; i < 4096; i += NTHR) tb[4095 - i] = bd[i]; }
    bf16x8 qf[4];
    load_q_frags<64, KSTR64>(F, qf, H0 + (size_t)(b * SEQ + t0) * EVEN_LD + C_QB + h * 64, EVEN_LD, Ks);
    f32x16 acc[2];
#pragma unroll
    for (int e = 0; e < 2; ++e)
#pragma unroll
        for (int i = 0; i < 16; ++i) acc[e][i] = 0.f;
    float S;
    { float qn = 0.f;
#pragma unroll
      for (int st = 0; st < 4; ++st)
#pragma unroll
          for (int q = 0; q < 8; ++q) { const float v = __uint_as_float(((unsigned)(unsigned short)qf[st][q]) << 16); qn += v * v; }
      qn = swap_sum(qn);
      const float k2 = __uint_as_float(((const unsigned*)(F.ws + WS_KMAX))[b * 16 + h]);
      const float U = sqrtf(qn * k2) * C_D64 * 1.001f + ((const float*)(F.ws + WS_KMAX + 256))[h] + 0.01f;
      S = fmaxf(U - 100.f, 0.f); }
    const bool noshift = __all(S == 0.f);
    float l = 0.f;
    const unsigned* mrow = mask + (size_t)(b * SEQ + t) * 128;
    const int jmax = (t0 + 255) >> 7;
    RowRegs<64> RK, RV;
    { const bf16* kg = H0 + (size_t)(b * SEQ) * EVEN_LD + C_KB + h * 64;
      fetch_rows128<64>(RK, kg, EVEN_LD, F.tid); fetch_rows128<64>(RV, kg + (C_VB - C_KB), EVEN_LD, F.tid); }
    u32x4 mwn = *(const u32x4*)(mrow);
    for (int j = 0; j <= jmax; ++j) {
        __syncthreads();
        put_rows128<64, KSTR64>(Ks, RK, F.tid); put_rows128<64, VSTR64>(Vs, RV, F.tid);
        const u32x4 mw4 = mwn;
        __syncthreads();
        if (j < jmax) { const bf16* kg = H0 + (size_t)(b * SEQ + 128 * (j + 1)) * EVEN_LD + C_KB + h * 64;
            fetch_rows128<64>(RK, kg, EVEN_LD, F.tid); fetch_rows128<64>(RV, kg + (C_VB - C_KB), EVEN_LD, F.tid);
            mwn = *(const u32x4*)(mrow + 4 * (j + 1)); }
#pragma unroll
        for (int kt = 0; kt < 4; ++kt) {
            const int s0 = 128 * j + 32 * kt;
            if (s0 > tw + 31) continue;
            const unsigned mws = mw4[kt] >> (4 * hf);
            f32x16 x = st_tile<64, KSTR64>(Ks, 32 * kt, qf, tl, hf);
            const LAS float* tp = tb + (4095 - (t - s0 - 4 * hf));
            if (noshift) {
#pragma unroll
                for (int i = 0; i < 16; ++i) {
                    const int ci = (i & 3) + 8 * (i >> 2);
                    const unsigned mm = (unsigned)__builtin_amdgcn_sbfe((int)mws, ci, 1);
                    x[i] = ex2(bfi_f(mm, x[i] * C_D64 + tp[ci], -INFINITY));
                    l += x[i];
                }
            } else {
#pragma unroll
                for (int i = 0; i < 16; ++i) {
                    const int ci = (i & 3) + 8 * (i >> 2);
                    const unsigned mm = (unsigned)__builtin_amdgcn_sbfe((int)mws, ci, 1);
                    x[i] = ex2(bfi_f(mm, x[i] * C_D64 + tp[ci], -INFINITY) - S);
                    l += x[i];
                }
            }
            const bf16x8 p0 = pack8(x, 0), p1 = pack8(x, 1);
            pv_tile<64, VSTR64>(acc, Vs, 32 * kt, p0, p1, lane);
        }
    }
    l = swap_sum(l);
    store_o_rows<64, KSTR64>(F, acc, 1.f / l, O + (size_t)(b * SEQ + t0) * DM + 1024 + h * 64, DM, Ks);
}

DI void store_o_rows_merge(Frame& F, const f32x16* acc, float m0v, float l0v, bf16* out0, const bf16* o1, const bf16* o2, const float* st, size_t tok0, int h, LAS unsigned char* buf) {
    constexpr int STR = KSTR128;
    int lane_ = F.lane; asm volatile("" : "+v"(lane_));
    const int tl = lane_ & 31, hf = lane_ >> 5;
    const float inv0 = 1.f / l0v;
    __syncthreads();
    LAS unsigned char* my = buf + F.wave * 32 * STR;
    LAS float* ml = (LAS float*)(buf + 8 * 32 * STR + F.wave * 256);
#pragma unroll
    for (int eb = 0; eb < 4; ++eb)
#pragma unroll
        for (int k = 0; k < 4; ++k) { u32x2 o; o.x = cvtpk(acc[eb][4 * k] * inv0, acc[eb][4 * k + 1] * inv0); o.y = cvtpk(acc[eb][4 * k + 2] * inv0, acc[eb][4 * k + 3] * inv0);
            *(LAS u32x2*)(my + tl * STR + (32 * eb + 8 * k + 4 * hf) * 2) = o; }
    if (hf == 0) { ml[2 * tl] = m0v; ml[2 * tl + 1] = l0v; }
    asm volatile("s_waitcnt lgkmcnt(0)" ::: "memory");
#pragma unroll
    for (int hb = 0; hb < 8; hb += 4) {
        u32x4 bq[4], cq[4]; float m1[4], s1[4], m2[4], s2[4];
#pragma unroll
        for (int k = 0; k < 4; ++k) { const int c = lane_ + 64 * (hb + k), r = c >> 4, q = c & 15;
            const size_t tok = tok0 + 32 * F.wave + r, off = tok * DM + h * 128 + q * 8, si = tok * 16 + h;
            bq[k] = *(const u32x4*)(o1 + off); cq[k] = *(const u32x4*)(o2 + off);
            m1[k] = st[(size_t)2 * MTOK * 16 + si]; s1[k] = st[(size_t)3 * MTOK * 16 + si]; m2[k] = st[(size_t)4 * MTOK * 16 + si]; s2[k] = st[(size_t)5 * MTOK * 16 + si]; }
#pragma unroll
        for (int k = 0; k < 4; ++k) { const int c = lane_ + 64 * (hb + k), r = c >> 4, q = c & 15;
            const u32x4 a = *(LAS const u32x4*)(my + r * STR + q * 16);
            const size_t off = (tok0 + 32 * F.wave + r) * DM + h * 128 + q * 8;
            const float m0 = ml[2 * r], s0 = ml[2 * r + 1];
            const float mm = fmaxf(m0, fmaxf(m1[k], m2[k]));
            float w0 = s0 * ex2(m0 - mm), w1 = s1[k] * ex2(m1[k] - mm), w2 = s2[k] * ex2(m2[k] - mm);
            const float inv = 1.f / (w0 + w1 + w2); w0 *= inv; w1 *= inv; w2 *= inv;
            u32x4 o;
#pragma unroll
            for (int e = 0; e < 4; ++e) {
                const unsigned ua = a[e], ub = bq[k][e], uc = cq[k][e];
                const float lo = w0 * __uint_as_float(ua << 16) + w1 * __uint_as_float(ub << 16) + w2 * __uint_as_float(uc << 16);
                const float hi = w0 * __uint_as_float(ua & 0xffff0000u) + w1 * __uint_as_float(ub & 0xffff0000u) + w2 * __uint_as_float(uc & 0xffff0000u);
                o[e] = cvtpk(lo, hi); }
            *(u32x4*)(out0 + off) = o; }
    }
}

struct DilItem { int g, b, h, r, nb; };
DI DilItem dil_item(int k) {
    DilItem it; int bh, sub;
    if (k < 1024) { it.g = 0; bh = k >> 4; sub = k & 15; }
    else { const int idx = k - 1024; bh = idx >> 5; it.g = 1 + ((idx >> 4) & 1); sub = idx & 15; }
    const int d = it.g == 0 ? 1 : (it.g == 1 ? 4 : 16), nbk = 16 / d;
    it.b = bh >> 4; it.h = bh & 15; it.r = sub / nbk; it.nb = sub % nbk; return it;
}
DI const bf16* dil_hm(Frame& F, int which, int b, int h, int pos) { return (const bf16*)(F.ws + WS_BIG) + (size_t)which * MTOK * 2048 + ((size_t)(b * 16 + h) * SEQ + pos) * 128; }
DI const bf16* dil_kptr(Frame& F, const DilItem& it, int st, size_t& gstr) {
    const int d = it.g == 0 ? 1 : (it.g == 1 ? 4 : 16); gstr = (size_t)d * 128;
    return dil_hm(F, 1, it.b, it.h, (256 * it.nb - 128 + 128 * st) * d + it.r);
}
DI void dil_unit(Frame& F, const DilItem& it, bool has_next, const DilItem& nx, RowRegs<128>& RK, RowRegs<128>& RV) {
    const int g = it.g, b = it.b, h = it.h, r = it.r, nb = it.nb;
    const bf16* H1 = (const bf16*)(F.ws + WS_BIG);
    bf16* O = g == 0 ? (bf16*)(F.ws + WS_XB) : (bf16*)(F.ws + WS_OG) + (size_t)(g - 1) * MTOK * DM;
    float* stM = (float*)(F.ws + WS_STAT) + (size_t)(2 * g) * MTOK * 16; float* stS = stM + (size_t)MTOK * 16;
    LAS unsigned char* Ks = F.lds + ATT_K_OFF; LAS unsigned char* Vs = F.lds + ATT_V_OFF;
    LAS float* tb = (LAS float*)(F.lds + ATT_TB_OFF);
    const int lane = F.lane, w = F.wave, tl = lane & 31, hf = lane >> 5;
    const int d = g == 0 ? 1 : (g == 1 ? 4 : 16);
    const int m0 = 256 * nb, iq = 32 * w + tl;
    const size_t tokq = (size_t)b * SEQ + (size_t)(m0 + iq) * d + r;
    __syncthreads();
    { const float* bd = (const float*)(F.ws + WS_BIASDIL) + (g * 16 + h) * 160;
      if (F.tid <= 128) tb[128 - F.tid] = bd[F.tid]; }
    bf16x8 qf[8];
    const size_t tok0 = (size_t)b * SEQ + (size_t)m0 * d + r;
    load_q_frags<128, KSTR128>(F, qf, dil_hm(F, 0, b, h, m0 * d + r), (size_t)d * 128, Ks);
    f32x16 acc[4];
#pragma unroll
    for (int e = 0; e < 4; ++e)
#pragma unroll
        for (int i = 0; i < 16; ++i) acc[e][i] = 0.f;
    float m = -1e30f, l = 0.f;
    const int st_lo = (nb == 0 ? 1 : 0);
    for (int st = st_lo; st < 3; ++st) {
        const int cbase = -128 + 128 * st;
        __syncthreads();
        put_rows128<128, KSTR128>(Ks, RK, F.tid); put_rows128<128, VSTR128>(Vs, RV, F.tid);
        __syncthreads();
        if (st < 2) { size_t gs; const bf16* kg = dil_kptr(F, it, st + 1, gs);
            fetch_rows128<128>(RK, kg, gs, F.tid); fetch_rows128<128>(RV, kg + (size_t)MTOK * 2048, gs, F.tid); }
        else if (has_next) { size_t gs; const bf16* kg = dil_kptr(F, nx, nx.nb == 0 ? 1 : 0, gs);
            fetch_rows128<128>(RK, kg, gs, F.tid); fetch_rows128<128>(RV, kg + (size_t)MTOK * 2048, gs, F.tid); }
#pragma unroll 1
        for (int kt = 0; kt < 4; ++kt) {
            const int c0 = cbase + 32 * kt;
            const int delta = 32 * w - c0;
            if (delta < 0 || delta > 128) continue;
            f32x16 x = st_tile<128, KSTR128>(Ks, 32 * kt, qf, tl, hf);
            const int jb = iq - c0 - 4 * hf;
            float mx = -1e30f;
            if (delta == 0 || delta == 128) {
                const unsigned mword = delta == 0 ? (0xffffffffu >> (31 - tl)) : (0xffffffffu << tl);
                const unsigned mws = mword >> (4 * hf);
                const LAS float* tp = tb + (128 - jb);
#pragma unroll
                for (int i = 0; i < 16; ++i) {
                    const int ci = (i & 3) + 8 * (i >> 2);
                    const unsigned mm = (unsigned)__builtin_amdgcn_sbfe((int)mws, ci, 1);
                    x[i] = bfi_f(mm, x[i] * C_D128 + tp[ci], -INFINITY);
                    mx = fmaxf(mx, x[i]);
                }
            } else {
                const LAS float* tp = tb + (128 - jb);
#pragma unroll
                for (int i = 0; i < 16; ++i) { const int ci = (i & 3) + 8 * (i >> 2); x[i] = x[i] * C_D128 + tp[ci]; mx = fmaxf(mx, x[i]); }
            }
            mx = swap_max(mx);
            const float mn = (mx > m + 8.f) ? mx : m, alpha = ex2(m - mn);
            float ps = 0.f;
#pragma unroll
            for (int i = 0; i < 16; ++i) { x[i] = ex2(x[i] - mn); ps += x[i]; }
            ps = swap_sum(ps);
            l = l * alpha + ps; m = mn;
            if (!__all(alpha == 1.f)) {
#pragma unroll
                for (int e = 0; e < 4; ++e)
#pragma unroll
                    for (int i = 0; i < 16; ++i) acc[e][i] *= alpha;
            }
            const bf16x8 p0 = pack8(x, 0), p1 = pack8(x, 1);
            pv_tile<128, VSTR128>(acc, Vs, 32 * kt, p0, p1, lane);
        }
    }
    if (g == 0) {
        store_o_rows_merge(F, acc, m, l, (bf16*)(F.ws + WS_XB), (const bf16*)(F.ws + WS_OG), (const bf16*)(F.ws + WS_OG) + (size_t)MTOK * DM, (const float*)(F.ws + WS_STAT), tok0, h, Ks);
    } else {
        store_o_rows<128, KSTR128>(F, acc, 1.f / l, O + tok0 * DM + h * 128, (size_t)d * DM, Ks);
        if (hf == 0) { stM[tokq * 16 + h] = m; stS[tokq * 16 + h] = l; }
    }
}

DI void phase_merge(Frame& F) {
    const int gw = F.bid * NWAVES + F.wave, NGW = F.G * NWAVES;
    bf16* o0 = (bf16*)(F.ws + WS_XB); const bf16* o1 = (const bf16*)(F.ws + WS_OG); const bf16* o2 = o1 + (size_t)MTOK * DM;
    const float* st = (const float*)(F.ws + WS_STAT);
    const int h = F.lane >> 2;
    for (int row = gw; row < MTOK; row += NGW) {
        const size_t si = (size_t)row * 16 + h, off = (size_t)row * DM + 32 * F.lane;
        u32x4 a[4], bq[4], c[4];
#pragma unroll
        for (int j = 0; j < 4; ++j) { a[j] = *(const u32x4*)(o0 + off + 8 * j); bq[j] = *(const u32x4*)(o1 + off + 8 * j); c[j] = *(const u32x4*)(o2 + off + 8 * j); }
        const float m0 = st[si], s0 = st[(size_t)MTOK * 16 + si], m1 = st[(size_t)2 * MTOK * 16 + si], s1 = st[(size_t)3 * MTOK * 16 + si],
                    m2 = st[(size_t)4 * MTOK * 16 + si], s2 = st[(size_t)5 * MTOK * 16 + si];
        const float mm = fmaxf(m0, fmaxf(m1, m2));
        float w0 = s0 * ex2(m0 - mm), w1 = s1 * ex2(m1 - mm), w2 = s2 * ex2(m2 - mm);
        const float inv = 1.f / (w0 + w1 + w2); w0 *= inv; w1 *= inv; w2 *= inv;
#pragma unroll
        for (int j = 0; j < 4; ++j) { u32x4 o;
#pragma unroll
            for (int q = 0; q < 4; ++q) {
                const unsigned ua = a[j][q], ub = bq[j][q], uc = c[j][q];
                const float lo = w0 * __uint_as_float(ua << 16) + w1 * __uint_as_float(ub << 16) + w2 * __uint_as_float(uc << 16);
                const float hi = w0 * __uint_as_float(ua & 0xffff0000u) + w1 * __uint_as_float(ub & 0xffff0000u) + w2 * __uint_as_float(uc & 0xffff0000u);
                o[q] = cvtpk(lo, hi); }
            *(u32x4*)(o0 + off + 8 * j) = o; }
    }
}

DI void phase_kmax(Frame& F) {
    const bf16* H0 = (const bf16*)(F.ws + WS_BIG); unsigned* kmax = (unsigned*)(F.ws + WS_KMAX);
    const int gw = F.bid * NWAVES + F.wave, NGW = F.G * NWAVES;
    for (int r8 = gw; r8 < MTOK / 8; r8 += NGW) {
        float best = 0.f;
#pragma unroll
        for (int k = 0; k < 8; ++k) {
            const bf16* p = H0 + (size_t)(r8 * 8 + k) * EVEN_LD + C_KB + 16 * F.lane;
            const u32x4 a = *(const u32x4*)p, b = *(const u32x4*)(p + 8);
            float ssq = 0.f;
#pragma unroll
            for (int q = 0; q < 4; ++q) { const float a0 = __uint_as_float(a[q] << 16), a1 = __uint_as_float(a[q] & 0xffff0000u), b0 = __uint_as_float(b[q] << 16), b1 = __uint_as_float(b[q] & 0xffff0000u);
                ssq += (a0 * a0 + a1 * a1) + (b0 * b0 + b1 * b1); }
            ssq += __shfl_xor(ssq, 1); ssq += __shfl_xor(ssq, 2);
            best = fmaxf(best, ssq);
        }
        if ((F.lane & 3) == 0) atomicMax(kmax + ((r8 * 8) >> 12) * 16 + (F.lane >> 2), __float_as_uint(best));
    }
}

DI int row_sum16(int x) {
    x += __builtin_amdgcn_update_dpp(0, x, 0xB1, 0xF, 0xF, true);
    x += __builtin_amdgcn_update_dpp(0, x, 0x4E, 0xF, 0xF, true);
    x += __builtin_amdgcn_update_dpp(0, x, 0x141, 0xF, 0xF, true);
    x += __builtin_amdgcn_update_dpp(0, x, 0x140, 0xF, 0xF, true);
    return x;
}
DI int wave_sum_i(int x) { x = row_sum16(x); return __builtin_amdgcn_readlane(x, 0) + __builtin_amdgcn_readlane(x, 16) + __builtin_amdgcn_readlane(x, 32) + __builtin_amdgcn_readlane(x, 48); }
DI int cnt4_ge(unsigned k0, unsigned k1, unsigned k2, unsigned k3, unsigned cand, int cl) {
    unsigned long long m0, m1, m2, m3;
    asm volatile("v_cmp_le_u32_e64 %1, %9, %5\n\tv_cmp_le_u32_e64 %2, %9, %6\n\tv_cmp_le_u32_e64 %3, %9, %7\n\tv_cmp_le_u32_e64 %4, %9, %8\n\t"
                 "v_addc_co_u32_e64 %0, %1, 0, %0, %1\n\tv_addc_co_u32_e64 %0, %2, 0, %0, %2\n\tv_addc_co_u32_e64 %0, %3, 0, %0, %3\n\tv_addc_co_u32_e64 %0, %4, 0, %0, %4"
                 : "+v"(cl), "=&s"(m0), "=&s"(m1), "=&s"(m2), "=&s"(m3) : "v"(k0), "v"(k1), "v"(k2), "v"(k3), "s"(cand));
    return cl;
}
DI unsigned f2ord(float f) { const unsigned u = __float_as_uint(f); return (u & 0x80000000u) ? ~u : (u | 0x80000000u); }
DI void index_unit(Frame& F, int b, int t0) {
    const bf16* H0 = (const bf16*)(F.ws + WS_BIG);
    unsigned long long* mask64 = (unsigned long long*)(F.ws + WS_MASK);
    LAS float* sc = (LAS float*)F.lds;
    const int lane = F.lane, w = F.wave, r = lane & 31, hf = lane >> 5;
    __syncthreads();
    const int rg = r >> 3, rhh = (r >> 2) & 1, rc = r & 3, a_tq = 2 * rhh + (rg >> 1), a_hd = 4 * (rg & 1) + rc;
    bf16x8 qa[2][4]; float wv[2][16];
#pragma unroll
    for (int mt = 0; mt < 2; ++mt) {
        const bf16* qp = H0 + (size_t)(b * SEQ + t0 + 4 * mt + a_tq) * EVEN_LD + C_QI + a_hd * 64 + 8 * hf;
#pragma unroll
        for (int st = 0; st < 4; ++st) qa[mt][st] = *(const bf16x8*)(qp + 16 * st);
#pragma unroll
        for (int q = 0; q < 2; ++q) {
            const bf16* wp = H0 + (size_t)(b * SEQ + t0 + 4 * mt + 2 * hf + q) * EVEN_LD + C_WI;
            const u32x4 wr = *(const u32x4*)wp;
#pragma unroll
            for (int k = 0; k < 4; ++k) { const unsigned u = wr[k]; wv[mt][8 * q + 2 * k] = bf2f((unsigned short)(u & 0xffff)) * 0.04419417382415922f; wv[mt][8 * q + 2 * k + 1] = bf2f((unsigned short)(u >> 16)) * 0.04419417382415922f; }
        }
    }
    const int nkt = (t0 + 8 + 31) >> 5;
    if (t0 + 8 > 256) for (int _r22 = 0; _r22 < (PROBE_PHASE == 22 ? 2 : 1); ++_r22) {
        bf16x8 kb[4], kn[4];
        { const bf16* kp = H0 + (size_t)(b * SEQ + 32 * w + r) * EVEN_LD + C_KI + 8 * hf;
          if (w < nkt) {
#pragma unroll
              for (int st = 0; st < 4; ++st) kb[st] = *(const bf16x8*)(kp + 16 * st); } }
        for (int kt = w; kt < nkt; kt += NWAVES) {
            const int s = 32 * kt + r;
            if (kt + NWAVES < nkt) { const bf16* kp = H0 + (size_t)(b * SEQ + s + 32 * NWAVES) * EVEN_LD + C_KI + 8 * hf;
#pragma unroll
                for (int st = 0; st < 4; ++st) kn[st] = *(const bf16x8*)(kp + 16 * st); }
#pragma unroll
            for (int mt = 0; mt < 2; ++mt) {
                f32x16 x;
#pragma unroll
                for (int i = 0; i < 16; ++i) x[i] = 0.f;
#pragma unroll
                for (int st = 0; st < 4; ++st) x = MFMA32(qa[mt][st], kb[st], x);
                float s0v = 0.f, s1v = 0.f;
#pragma unroll
                for (int i = 0; i < 8; ++i) { s0v += wv[mt][i] * fmaxf(x[i], 0.f); s1v += wv[mt][8 + i] * fmaxf(x[8 + i], 0.f); }
                const int tq0 = 4 * mt + 2 * hf;
                sc[tq0 * 4096 + s] = (s <= t0 + tq0) ? (s0v + 0.f) : -1e30f;
                sc[(tq0 + 1) * 4096 + s] = (s <= t0 + tq0 + 1) ? (s1v + 0.f) : -1e30f;
            }
#pragma unroll
            for (int st = 0; st < 4; ++st) kb[st] = kn[st];
        }
    }
    __syncthreads();
    const int t = t0 + w;
    unsigned long long myword = 0ull;
    for (int _r21 = 0; _r21 < (PROBE_PHASE == 21 ? 2 : 1); ++_r21)
    if (t < 256) {
        const int nbits = t + 1 - 64 * lane;
        myword = nbits >= 64 ? ~0ull : (nbits <= 0 ? 0ull : ((1ull << nbits) - 1ull));
    } else {
        unsigned key[64];
#pragma unroll
        for (int i = 0; i < 64; ++i) { const int s = 64 * i + lane; key[i] = (s <= t) ? f2ord(sc[w * 4096 + s]) : 0u; }
        unsigned res = 0u;
        const int nreg = (t >> 6) + 1;
#pragma unroll 1
        for (int bit = 31; bit >= 0; --bit) {
            const unsigned cand = res | (1u << bit);
            int cl = 0;
#pragma unroll
            for (int gq = 0; gq < 8; ++gq) if (8 * gq < nreg) {
#pragma unroll
                for (int i = 8 * gq; i < 8 * gq + 8; i += 4) cl = cnt4_ge(key[i], key[i + 1], key[i + 2], key[i + 3], cand, cl); }
            const int cnt = wave_sum_i(cl);
            if (cnt >= 256) { res = cand; if (cnt == 256) break; }
        }
        int need, eqc;
        { int cg_ = 0, ce_ = 0;
#pragma unroll
          for (int gq = 0; gq < 8; ++gq) if (8 * gq < nreg) {
#pragma unroll
              for (int i = 8 * gq; i < 8 * gq + 8; ++i) { cg_ += (key[i] > res) ? 1 : 0; ce_ += (key[i] == res) ? 1 : 0; } }
          need = 256 - wave_sum_i(cg_); eqc = wave_sum_i(ce_); }
        if (eqc == need) {
#pragma unroll
            for (int i = 0; i < 64; ++i) { const unsigned long long sb = __ballot(key[i] >= res);
                if (lane == i) myword = sb; }
        } else {
            const unsigned long long lt = (1ull << lane) - 1ull;
            int running = 0;
#pragma unroll
            for (int i = 0; i < 64; ++i) {
                const bool gtb = key[i] > res, eq = key[i] == res;
                const unsigned long long tbm = __ballot(eq);
                const int rank = running + __popcll(tbm & lt);
                const unsigned long long sb = __ballot(gtb || (eq && rank < need));
                if (lane == i) myword = sb;
                running += __popcll(tbm);
            }
        }
    }
    mask64[(size_t)(b * SEQ + t) * 64 + lane] = myword;
}

#define SNAKE_FOR(NITEMS, k) for (int _rd = 0, k; _rd * F.G < (NITEMS); ++_rd) if ((k = (_rd & 1) ? _rd * F.G + (F.G - 1 - F.bid) : _rd * F.G + F.bid) < (NITEMS))

#define XB_TMO      128
#define XB_XCNT(j)  (256  + 64 * (j))
#define XB_XSUB(j)  (1280 + 64 * (j))
#define XB_XGEN(j)  (2304 + 64 * (j))
#define XB_TOP      3328
#define XB_TOPGEN   3392
#define XCD_BAR_WORDS 3456
#define XB_SPIN_CAP (1u << 18)

__device__ __forceinline__ unsigned xb_ld(unsigned* p)              { return __hip_atomic_load(p, __ATOMIC_RELAXED, __HIP_MEMORY_SCOPE_AGENT); }
__device__ __forceinline__ unsigned xb_add(unsigned* p, unsigned v) { return __hip_atomic_fetch_add(p, v, __ATOMIC_RELAXED, __HIP_MEMORY_SCOPE_AGENT); }
__device__ __forceinline__ unsigned xb_xcc_id() { return (unsigned)__builtin_amdgcn_s_getreg((3 << 11) | 20) & 0xFu; }
#define XB_SPIN(cond, bar) do { unsigned _sp = 0; while (cond) { __builtin_amdgcn_s_sleep(1); \
    if ((++_sp & 255u) == 0u) { if (xb_ld(&(bar)[XB_TMO])) break; if (_sp > XB_SPIN_CAP) { atomicAdd(&(bar)[XB_TMO], 1u); break; } } } } while (0)

struct XcdBarrier {
    unsigned* bar; unsigned x;
    volatile LAS unsigned* st;
};

__device__ __forceinline__ XcdBarrier xcd_barrier_post(unsigned* bar, volatile LAS unsigned* st) {
    XcdBarrier b; b.bar = bar; b.x = xb_xcc_id(); b.st = st;
    if (threadIdx.x == 0) (void)xb_add(&bar[XB_XCNT(b.x)], 1u);
    return b;
}
__device__ __forceinline__ void xcd_barrier_complete(unsigned* bar, unsigned x, unsigned& nloc, unsigned& nx) {
    const unsigned G = gridDim.x * gridDim.y * gridDim.z;
    unsigned sum, cnt, mine, sp = 0u;
    for (;;) {
        sum = 0u; cnt = 0u; mine = 0u;
#pragma unroll
        for (unsigned j = 0; j < 16; ++j) { const unsigned c = xb_ld(&bar[XB_XCNT(j)]); sum += c; cnt += (c > 0u) ? 1u : 0u; mine = (j == x) ? c : mine; }
        if (sum == G) break;
        __builtin_amdgcn_s_sleep(1);
        if ((++sp & 255u) == 0u) { if (xb_ld(&bar[XB_TMO])) break; if (sp > XB_SPIN_CAP) { atomicAdd(&bar[XB_TMO], 1u); break; } }
    }
    nloc = mine > 0u ? mine : 1u; nx = cnt > 0u ? cnt : 1u;
}

__device__ __forceinline__ void xcd_barrier(const XcdBarrier& b) {
    asm volatile("s_waitcnt vmcnt(0)" ::: "memory");
    __syncthreads();
    if (threadIdx.x == 0) {
        unsigned* bar = b.bar;
        __builtin_amdgcn_s_waitcnt(0);
        unsigned nloc = b.st[0], nx = b.st[1];
        if (nloc == 0u) { xcd_barrier_complete(bar, b.x, nloc, nx); b.st[0] = nloc; b.st[1] = nx; }
        const unsigned old = xb_add(&bar[XB_XSUB(b.x)], 1u);
        const unsigned gen = old / nloc;
        if (old + 1u == (gen + 1u) * nloc) {
            __builtin_amdgcn_fence(__ATOMIC_RELEASE, "agent");
            asm volatile("s_waitcnt vmcnt(0)" ::: "memory");
            const unsigned og = xb_add(&bar[XB_TOP], 1u);
            const unsigned tg = og / nx;
            if (og + 1u == (tg + 1u) * nx) xb_add(&bar[XB_TOPGEN], 1u);
            else XB_SPIN(xb_ld(&bar[XB_TOPGEN]) == tg, bar);
            __builtin_amdgcn_fence(__ATOMIC_ACQUIRE, "agent");
            xb_add(&bar[XB_XGEN(b.x)], 1u);
            asm volatile("s_waitcnt vmcnt(0)" ::: "memory");
        } else {
            XB_SPIN(xb_ld(&bar[XB_XGEN(b.x)]) == gen, bar);
            __builtin_amdgcn_fence(__ATOMIC_ACQUIRE, "agent");
            asm volatile("s_waitcnt vmcnt(0)" ::: "memory");
        }
    }
    __syncthreads();
}

struct Args { const float* in[12]; float* out; unsigned char* ws; int ph_lo, ph_hi; };

DI void gemm_bf16(Frame& F, const bf16* A, const bf16* Bt, int N, int K, bf16* O, int ldc, bool sq) {
    pg8::Gemm g{A, Bt, MTOK, N, K}; pg8::StaticOrder S; S.init(MTOK, N, F.G, F.bid);
    if (sq) { pg8::EpiBf16<2> E{O, ldc}; pg8::gemm_phase<pg8::EpiBf16<2>, pg8::StaticOrder, PG8_ALIGN, PG8_SP2>((PG8_LAS unsigned char*)F.lds, g, S, E); }
    else { pg8::EpiBf16<0> E{O, ldc}; pg8::gemm_phase<pg8::EpiBf16<0>, pg8::StaticOrder, PG8_ALIGN, PG8_SP2>((PG8_LAS unsigned char*)F.lds, g, S, E); }
}
DI void gemm_res_ln(Frame& F, const bf16* A, const bf16* Bt, int K, float* out, const float* g, const float* b) {
    pg8::Gemm gm{A, Bt, MTOK, DM, K}; pg8::StaticOrder S; S.init(MTOK, DM, F.G, F.bid);
    pg8::EpiResLnF32 E{out, out, DM, DN_ALPHA, (const float*)(F.ws + WS_LNST), g, b};
    pg8::gemm_phase<pg8::EpiResLnF32, pg8::StaticOrder, PG8_ALIGN, PG8_SP2>((PG8_LAS unsigned char*)F.lds, gm, S, E);
}
DI void gemm_res(Frame& F, const bf16* A, const bf16* Bt, int K, const float* res, float* out) {
    pg8::Gemm g{A, Bt, MTOK, DM, K}; pg8::StaticOrder S; S.init(MTOK, DM, F.G, F.bid);
    pg8::EpiResF32 E{res, out, DM, DN_ALPHA};
    pg8::gemm_phase<pg8::EpiResF32, pg8::StaticOrder, PG8_ALIGN, PG8_SP2>((PG8_LAS unsigned char*)F.lds, g, S, E);
}

__global__ void __launch_bounds__(NTHR, 2) fwd(Args args) {
    extern __shared__ __attribute__((aligned(16))) unsigned char lds_raw[];
    Frame F;
    F.lds = (LAS unsigned char*)lds_raw;
    F.tid = threadIdx.x; F.lane = F.tid & 63; F.wave = __builtin_amdgcn_readfirstlane(F.tid >> 6);
    F.G = gridDim.x; F.bid = blockIdx.x;
#pragma unroll
    for (int i = 0; i < 12; ++i) F.in[i] = args.in[i];
    F.out = args.out; F.ws = args.ws;
    unsigned char* ws = args.ws;
    bf16* XB = (bf16*)(ws + WS_XB); bf16* BIG = (bf16*)(ws + WS_BIG);
    const bf16* WIN = (const bf16*)(ws + WS_WIN); const bf16* WOUT = (const bf16*)(ws + WS_WOUT);
    const bf16* W1 = (const bf16*)(ws + WS_W1); const bf16* W2 = (const bf16*)(ws + WS_W2);
    const int lo = args.ph_lo, hi = args.ph_hi;
#define IN(k) (lo <= (k) && (k) < hi)
#define SEAM(k) do { if (IN(k) && IN((k) + 1)) { if ((k) == 0) { cg::this_grid().sync(); bar = xcd_barrier_post(barw, MISC); } else { xcd_barrier(bar); } } } while (0)
    volatile LAS unsigned* MISC = (volatile LAS unsigned*)(F.lds + 131072 + 64);
    unsigned* barw = (unsigned*)ws;
    if (F.tid < 4) MISC[F.tid] = 0u;
    if (lo == 0 && F.bid == 0) for (int i = F.tid; i < XCD_BAR_WORDS; i += NTHR) barw[i] = 0u;
    __syncthreads();
    XcdBarrier bar; bar.bar = barw; bar.x = 0; bar.st = MISC;

    if (IN(0)) REPS(0) { prep_weights(F, 0); prep_misc(F); } SEAM(0);
    if (IN(1)) { gemm_bf16(F, XB, WIN, EVEN_LD, DM, BIG, EVEN_LD, false); if (PROBE_PHASE == 1) { __syncthreads(); gemm_bf16(F, XB, WIN, EVEN_LD, DM, BIG, EVEN_LD, false); } } SEAM(1);
    if (IN(2)) REPS(2) { phase_kmax(F); SNAKE_FOR(2048, k) { index_unit(F, k & 3, 8 * (511 - (k >> 2))); } } SEAM(2);
    if (IN(3)) {
        if (F.G == 256) {
            const int vcu3 = (F.bid % 8) * 32 + F.bid / 8, grp = vcu3 >> 4, j16 = vcu3 & 15, j8 = (j16 + 8) & 15;
#pragma unroll 1
            for (int rd = 0; rd < 4; ++rd) { const int bh = grp * 4 + rd; const int qb = rd == 0 ? 15 - j16 : (rd == 1 ? j16 : (rd == 2 ? 15 - j8 : j8));
                dsa_unit(F, bh >> 4, bh & 15, qb); }
#pragma unroll 1
            for (int rd = 0; rd < 2; ++rd) { const int bh = grp * 2 + rd; const int qb = rd == 0 ? 15 - j16 : j16; sb_unit(F, bh >> 3, bh & 7, qb); }
        } else {
        SNAKE_FOR(1024 + 512, k) {
            if (k < 1024) { const int qb = 15 - (k >> 6), bh = k & 63; dsa_unit(F, bh >> 4, bh & 15, qb); }
            else { const int kk = k - 1024; const int qb = 15 - (kk >> 5), bh = kk & 31; sb_unit(F, bh >> 3, bh & 7, qb); }
        }
        }
    } SEAM(3);
    if (IN(4)) { gemm_res(F, XB, WOUT, DM, F.in[0], F.out); } SEAM(4);
    if (IN(5)) { phase_ln(F, F.in[6], F.in[7], true); if (PROBE_PHASE == 99) { for (int q = 0; q < 20; ++q) xcd_barrier(bar); } } SEAM(5);
    if (IN(6)) { gemm_bf16(F, XB, W1, DFF, DM, BIG, DFF, true); } SEAM(6);
    if (IN(7)) { gemm_res_ln(F, BIG, W2, DFF, F.out, F.in[6], F.in[7]); } SEAM(7);
    if (IN(8)) { phase_ln(F, F.in[10], F.in[11], true); __syncthreads(); prep_weights(F, 1); } SEAM(8);
    if (IN(9)) { pg8::Gemm g{XB, WIN, MTOK, ODD_IN, DM}; pg8::StaticOrder S; S.init(MTOK, ODD_IN, F.G, F.bid); pg8::EpiBf16HeadMajor E{BIG};
        pg8::gemm_phase<pg8::EpiBf16HeadMajor, pg8::StaticOrder, PG8_ALIGN, PG8_SP2>((PG8_LAS unsigned char*)F.lds, g, S, E); } SEAM(9);
    const int vcu = (F.G % 8 == 0) ? (F.bid % 8) * (F.G / 8) + F.bid / 8 : F.bid;
#define DIL_RANGE(LO, HI) do { RowRegs<128> RK, RV; \
        if ((LO) + vcu < (HI)) { const DilItem it = dil_item((LO) + vcu); size_t gs; const bf16* kg = dil_kptr(F, it, it.nb == 0 ? 1 : 0, gs); \
            fetch_rows128<128>(RK, kg, gs, F.tid); fetch_rows128<128>(RV, kg + (size_t)MTOK * 2048, gs, F.tid); } \
        for (int k = (LO) + vcu; k < (HI); k += F.G) { \
            const DilItem it = dil_item(k); const bool hn = k + F.G < (HI); const DilItem nx = dil_item(hn ? k + F.G : k); \
            dil_unit(F, it, hn, nx, RK, RV); } } while (0)
    if (IN(10)) { DIL_RANGE(1024, 3072); } SEAM(10);
    if (IN(11)) { DIL_RANGE(0, 1024); } SEAM(11);
#undef DIL_RANGE
    if (IN(12)) { gemm_res_ln(F, XB, WOUT, DM, F.out, F.in[10], F.in[11]); } SEAM(12);
    if (IN(13)) { phase_ln(F, F.in[6] + DM, F.in[7] + DM, true); } SEAM(13);
    if (IN(14)) { gemm_bf16(F, XB, W1, DFF, DM, BIG, DFF, true); } SEAM(14);
    if (IN(15)) { gemm_res_ln(F, BIG, W2, DFF, F.out, F.in[6] + DM, F.in[7] + DM); } SEAM(15);
    if (IN(16)) { phase_ln(F, F.in[10] + DM, F.in[11] + DM, false); }
#undef IN
#undef SEAM
}

extern "C" void kernel_launch(void* const* d_in, const int* in_sizes, int n_in, void* d_out, int out_size, void* d_ws, size_t ws_size, hipStream_t stream) {
    static int grid = 0;
    if (grid == 0) {
        if (n_in != 12 || out_size != MTOK * DM || ws_size < WS_END) { fprintf(stderr, "kernel_launch: unexpected shapes (n_in %d out %d ws %zu)\n", n_in, out_size, ws_size); grid = -1; return; }
        int dev = 0, cus = 0, per_cu = 0;
        hipGetDevice(&dev); hipDeviceGetAttribute(&cus, hipDeviceAttributeMultiprocessorCount, dev);
        if (hipFuncSetAttribute((const void*)fwd, hipFuncAttributeMaxDynamicSharedMemorySize, LDS_BYTES) != hipSuccess) { fprintf(stderr, "kernel_launch: hipFuncSetAttribute failed\n"); grid = -1; return; }
        if (hipOccupancyMaxActiveBlocksPerMultiprocessor(&per_cu, (const void*)fwd, NTHR, LDS_BYTES) != hipSuccess || per_cu < 1) { fprintf(stderr, "kernel_launch: occupancy query says %d\n", per_cu); per_cu = 1; }
        (void)hipGetLastError();
        grid = cus * 1;
    }
    if (grid < 0) return;
    Args a{};
    for (int i = 0; i < 12; ++i) a.in[i] = (const float*)d_in[i];
    a.out = (float*)d_out; a.ws = (unsigned char*)d_ws;
#if MK_PER_PHASE
    for (int p = 0; p < N_PHASES; ++p) { a.ph_lo = p; a.ph_hi = p + 1; hipLaunchKernelGGL(fwd, dim3(grid), dim3(NTHR), LDS_BYTES, stream, a); }
#else
    a.ph_lo = 0; a.ph_hi = N_PHASES;
    void* kargs[] = {&a};
    hipError_t e = hipLaunchCooperativeKernel((const void*)fwd, dim3(grid), dim3(NTHR), kargs, LDS_BYTES, stream);
    if (e != hipSuccess) fprintf(stderr, "cooperative launch failed: %s (grid %d)\n", hipGetErrorString(e), grid);
#endif
}
```
